# Optimizing an MI355X kernel written in HIP

```python
import jax, jax.numpy as jnp
from jax import lax
import numpy as np

D_MODEL = 2048
BATCH = 8
SEQ = 4096
DEPTH = 1
DEC_BATCH = 32
DEC_SEQ = 32
PAST_LEN = 1024

CHUNK = 64
N_HEADS = 16
N_KV_HEADS = 4
HEAD_DIM = 64
GROUP = N_HEADS // N_KV_HEADS
ATTN_DIM = N_HEADS * HEAD_DIM
KV_DIM = N_KV_HEADS * HEAD_DIM
WINDOW = 128
WIN_CHUNKS = WINDOW // CHUNK
CONV_DIM = 1024
CONV_WIDTH = 31
ROPE_THETA = 10000.0
RMS_EPS = 1e-6
LN_EPS = 1e-5
NEG_INF = -1e30

Q_END = ATTN_DIM
K_END = Q_END + KV_DIM
V_END = K_END + KV_DIM
GA_END = V_END + ATTN_DIM
CU_END = GA_END + 2 * CONV_DIM
GB_END = CU_END + CONV_DIM
IN_DIM = GB_END + 2 * D_MODEL
IN_SPLITS = (Q_END, K_END, V_END, GA_END, CU_END, GB_END)

kernel_name = "hybrid_swa_sink_conformer_conv_stream_step"


def _rmsnorm(x, g):
    x32 = x.astype(jnp.float32)
    y = x32 * lax.rsqrt(jnp.mean(x32 * x32, axis=-1, keepdims=True) + RMS_EPS)
    return (y * g.astype(jnp.float32)).astype(x.dtype)


def _rope(x, pos):
    half = HEAD_DIM // 2
    inv = ROPE_THETA ** (-2.0 * jnp.arange(half, dtype=jnp.float32) / HEAD_DIM)
    ang = pos.astype(jnp.float32)[:, None] * inv[None, :]
    cos = jnp.cos(ang)[None, :, None, :]
    sin = jnp.sin(ang)[None, :, None, :]
    x1 = x[..., :half].astype(jnp.float32)
    x2 = x[..., half:].astype(jnp.float32)
    out = jnp.concatenate([x1 * cos - x2 * sin, x2 * cos + x1 * sin], axis=-1)
    return out.astype(x.dtype)


def _in_proj(x, c, norm_g, w_ada, b_ada, w_in, pos):
    mod = jax.nn.silu(c) @ w_ada + b_ada
    shift, scale, gate = jnp.split(mod[:, None, :], 3, axis=-1)
    h = _rmsnorm(x, norm_g) * (1 + scale) + shift
    z = h @ w_in
    q, k, v, ga, cu, gb, mg = jnp.split(z, IN_SPLITS, axis=-1)
    b, t, _ = x.shape
    q = _rope(q.reshape(b, t, N_HEADS, HEAD_DIM), pos)
    k = _rope(k.reshape(b, t, N_KV_HEADS, HEAD_DIM), pos)
    v = v.reshape(b, t, N_KV_HEADS, HEAD_DIM)
    u = cu[..., :CONV_DIM] * jax.nn.sigmoid(cu[..., CONV_DIM:])
    return q, k, v, ga, u, gb, mg, gate


def _attend(q, k, v, mask, sinks):
    s = jnp.einsum('...qkgd,...skd->...kgqs', q, k,
                   preferred_element_type=jnp.float32) * (HEAD_DIM ** -0.5)
    if mask is not None:
        s = jnp.where(mask, s, NEG_INF)
    sink = sinks.astype(jnp.float32).reshape(N_KV_HEADS, GROUP)[:, :, None, None]
    m = jnp.maximum(jnp.max(s, axis=-1, keepdims=True), sink)
    e = jnp.exp(s - m)
    p = e / (jnp.sum(e, axis=-1, keepdims=True) + jnp.exp(sink - m))
    return jnp.einsum('...kgqs,...skd->...qkgd', p.astype(v.dtype), v)


def _band_attention(q, k, v, sinks):
    b, s = q.shape[0], q.shape[1]
    nc = s // CHUNK
    qc = q.reshape(b, nc, CHUNK, N_KV_HEADS, GROUP, HEAD_DIM)
    kc = k.reshape(b, nc, CHUNK, N_KV_HEADS, HEAD_DIM)
    vc = v.reshape(b, nc, CHUNK, N_KV_HEADS, HEAD_DIM)
    padw = ((0, 0), (WIN_CHUNKS, 0), (0, 0), (0, 0), (0, 0))
    kp = jnp.pad(kc, padw)
    vp = jnp.pad(vc, padw)
    kb = jnp.concatenate([kp[:, i:i + nc] for i in range(WIN_CHUNKS + 1)], axis=2)
    vb = jnp.concatenate([vp[:, i:i + nc] for i in range(WIN_CHUNKS + 1)], axis=2)
    src = jnp.arange(nc)[:, None] - WIN_CHUNKS + jnp.arange(WIN_CHUNKS + 1)[None, :]
    valid = jnp.repeat(src >= 0, CHUNK, axis=1)
    mask = valid[:, None, None, None, :]
    o = _attend(qc, kb, vb, mask, sinks)
    return o.reshape(b, s, ATTN_DIM)


def _conv_branch(u_ctx, w_dw, b_dw, ln_g, ln_b):
    y = lax.conv_general_dilated(u_ctx, w_dw[:, None, :], window_strides=(1,),
                                 padding='VALID',
                                 dimension_numbers=('NWC', 'WIO', 'NWC'),
                                 feature_group_count=CONV_DIM) + b_dw
    y32 = y.astype(jnp.float32)
    mu = jnp.mean(y32, axis=-1, keepdims=True)
    var = jnp.mean(jnp.square(y32 - mu), axis=-1, keepdims=True)
    yn = (y32 - mu) * lax.rsqrt(var + LN_EPS) * ln_g.astype(jnp.float32) + ln_b.astype(jnp.float32)
    return jax.nn.silu(yn).astype(u_ctx.dtype)


def _out_proj(x, attn_o, conv_o, ga, gb, mg, gate, w_proj_a, w_proj_b, w_out):
    pa = (attn_o * jax.nn.silu(ga)) @ w_proj_a
    pb = (conv_o * jax.nn.silu(gb)) @ w_proj_b
    merged = jax.nn.sigmoid(mg[..., :D_MODEL]) * pa + jax.nn.sigmoid(mg[..., D_MODEL:]) * pb
    return x + gate * (merged @ w_out)


def setup_inputs(seed: int = 0) -> dict:
    key = jax.random.key(seed)
    ks = jax.random.split(key, 20)
    f32 = jnp.float32
    win_cache = min(WINDOW, PAST_LEN)
    nrm = lambda k, shp, s: jax.random.normal(k, shp, f32) * s
    return {
        "x_prompt": nrm(ks[0], (BATCH, SEQ, D_MODEL), 1.0),
        "x_sample": nrm(ks[1], (DEC_BATCH, DEC_SEQ, D_MODEL), 1.0),
        "c_prompt": nrm(ks[2], (BATCH, D_MODEL), 1.0),
        "c_sample": nrm(ks[3], (DEC_BATCH, D_MODEL), 1.0),
        "cache_k": nrm(ks[4], (DEPTH, DEC_BATCH, win_cache, N_KV_HEADS, HEAD_DIM), 1.0),
        "cache_v": nrm(ks[5], (DEPTH, DEC_BATCH, win_cache, N_KV_HEADS, HEAD_DIM), 1.0),
        "state_conv": nrm(ks[6], (DEPTH, DEC_BATCH, CONV_WIDTH - 1, CONV_DIM), 0.5),
        "norm_g": 1.0 + nrm(ks[7], (DEPTH, D_MODEL), 0.02),
        "w_ada": nrm(ks[8], (DEPTH, D_MODEL, 3 * D_MODEL), 0.5 * D_MODEL ** -0.5),
        "b_ada": nrm(ks[9], (DEPTH, 3 * D_MODEL), 0.02),
        "w_in": nrm(ks[10], (DEPTH, D_MODEL, IN_DIM), D_MODEL ** -0.5),
        "sinks": nrm(ks[11], (DEPTH, N_HEADS), 1.0),
        "w_dw": nrm(ks[12], (DEPTH, CONV_WIDTH, CONV_DIM), CONV_WIDTH ** -0.5),
        "b_dw": nrm(ks[13], (DEPTH, CONV_DIM), 0.02),
        "ln_g": 1.0 + nrm(ks[14], (DEPTH, CONV_DIM), 0.02),
        "ln_b": nrm(ks[15], (DEPTH, CONV_DIM), 0.02),
        "w_proj_a": nrm(ks[16], (DEPTH, ATTN_DIM, D_MODEL), ATTN_DIM ** -0.5),
        "w_proj_b": nrm(ks[17], (DEPTH, CONV_DIM, D_MODEL), CONV_DIM ** -0.5),
        "w_out": nrm(ks[18], (DEPTH, D_MODEL, D_MODEL), D_MODEL ** -0.5),
        "final_g": 1.0 + nrm(ks[19], (D_MODEL,), 0.02),
    }


def reference(x_prompt, x_sample, c_prompt, c_sample, cache_k, cache_v, state_conv,
              norm_g, w_ada, b_ada, w_in, sinks, w_dw, b_dw, ln_g, ln_b,
              w_proj_a, w_proj_b, w_out, final_g):
    seq = x_prompt.shape[1]
    dec_seq = x_sample.shape[1]
    n_win = cache_k.shape[2]
    pos_p = jnp.arange(seq)
    pos_s = PAST_LEN + jnp.arange(dec_seq)
    xp, xs = x_prompt, x_sample
    kp_l, vp_l, cp_l, ks_l, vs_l, cs_l = [], [], [], [], [], []
    for l in range(DEPTH):
        q, k, v, ga, u, gb, mg, gate = _in_proj(xp, c_prompt, norm_g[l], w_ada[l], b_ada[l], w_in[l], pos_p)
        attn_o = _band_attention(q, k, v, sinks[l])
        u_ctx = jnp.pad(u, ((0, 0), (CONV_WIDTH - 1, 0), (0, 0)))
        conv_o = _conv_branch(u_ctx, w_dw[l], b_dw[l], ln_g[l], ln_b[l])
        xp = _out_proj(xp, attn_o, conv_o, ga, gb, mg, gate, w_proj_a[l], w_proj_b[l], w_out[l])
        kp_l.append(k[:, -n_win:])
        vp_l.append(v[:, -n_win:])
        cp_l.append(u[:, -(CONV_WIDTH - 1):])
        q, k, v, ga, u, gb, mg, gate = _in_proj(xs, c_sample, norm_g[l], w_ada[l], b_ada[l], w_in[l], pos_s)
        k_all = jnp.concatenate([cache_k[l], k], axis=1)
        v_all = jnp.concatenate([cache_v[l], v], axis=1)
        qs = q.reshape(q.shape[0], dec_seq, N_KV_HEADS, GROUP, HEAD_DIM)
        attn_o = _attend(qs, k_all, v_all, None, sinks[l]).reshape(q.shape[0], dec_seq, ATTN_DIM)
        u_ctx = jnp.concatenate([state_conv[l], u], axis=1)
        conv_o = _conv_branch(u_ctx, w_dw[l], b_dw[l], ln_g[l], ln_b[l])
        xs = _out_proj(xs, attn_o, conv_o, ga, gb, mg, gate, w_proj_a[l], w_proj_b[l], w_out[l])
        ks_l.append(k_all[:, -n_win:])
        vs_l.append(v_all[:, -n_win:])
        cs_l.append(u_ctx[:, -(CONV_WIDTH - 1):])
    y_prompt = _rmsnorm(xp, final_g)
    y_sample = _rmsnorm(xs, final_g)
    new_k_prompt = jnp.stack(kp_l)
    new_v_prompt = jnp.stack(vp_l)
    new_conv_prompt = jnp.stack(cp_l)
    new_k_sample = jnp.stack(ks_l)
    new_v_sample = jnp.stack(vs_l)
    new_conv_sample = jnp.stack(cs_l)
    return (y_prompt, y_sample, new_k_prompt, new_v_prompt, new_conv_prompt, new_k_sample, new_v_sample, new_conv_sample)
```

```cpp
#include <hip/hip_runtime.h>
#include <cstdio>
#include <cstdint>

#define GAS __attribute__((address_space(1)))
#define LAS __attribute__((address_space(3)))
typedef unsigned short bf16_t;
typedef short bf16x8 __attribute__((ext_vector_type(8)));
typedef short s16x4 __attribute__((ext_vector_type(4)));
typedef float f32x2 __attribute__((ext_vector_type(2)));
typedef float f32x4 __attribute__((ext_vector_type(4)));
typedef float f32x16 __attribute__((ext_vector_type(16)));
typedef unsigned u32x2 __attribute__((ext_vector_type(2)));
typedef unsigned u32x4 __attribute__((ext_vector_type(4)));
typedef int i32x4 __attribute__((ext_vector_type(4)));
typedef int i32x8 __attribute__((ext_vector_type(8)));

constexpr int DM = 2048, NB_P = 8, SEQ = 4096, NB_S = 32, SEQ_S = 32, PAST = 1024;
constexpr int MP = NB_P * SEQ, MS = NB_S * SEQ_S, M = MP + MS;
constexpr int NQ = 1024, NKV = 256, CD = 1024, IN_DIM = 9728, NMG = 4096;
constexpr int NMOD = 40, MOD_N = 3 * DM, KS_ADA = 8;
constexpr int CW = 31, HIST = 30, WIN = 128;
constexpr float RMS_EPS = 1e-6f, LN_EPS = 1e-5f;
constexpr float LOG2E = 1.4426950408889634f;
constexpr float W8_SCALE = 32.0f, MG8_SCALE = 8.0f, A8_SCALE = 16.0f;
constexpr int PK_H8 = 2048, PK_W8 = 2048, PK_A12 = 1024, PK_WAB = 1024, PK_WO = 2048, PK_MG = 2048 + 128;
constexpr float QSCALE = 0.125f * LOG2E;

constexpr size_t OY = 0;
constexpr size_t OK_P = (size_t)M * DM;
constexpr size_t OV_P = OK_P + (size_t)NB_P * WIN * NKV;
constexpr size_t OC_P = OV_P + (size_t)NB_P * WIN * NKV;
constexpr size_t OK_S = OC_P + (size_t)NB_P * HIST * CD;
constexpr size_t OV_S = OK_S + (size_t)NB_S * WIN * NKV;
constexpr size_t OC_S = OV_S + (size_t)NB_S * WIN * NKV;
constexpr size_t OUT_TOTAL = OC_S + (size_t)NB_S * HIST * CD;

constexpr size_t MiB = 1u << 20;
constexpr size_t WS_CTL = 0, CTL_ZERO_BYTES = 1 * MiB;
constexpr size_t WS_GATE = 1 * MiB;
constexpr size_t WS_ROPE_C = 1 * MiB + 512 * 1024, WS_ROPE_S = 2 * MiB;
constexpr size_t WS_RSS = 8 * MiB;
constexpr size_t WS_PART = 8 * MiB;
constexpr size_t WS_WIN = 24 * MiB;
constexpr size_t WS_WA = 62 * MiB, WS_WB = 66 * MiB, WS_WO = 70 * MiB;
constexpr size_t WS_H = 80 * MiB;
constexpr size_t WS_Q = 212 * MiB;
constexpr size_t WS_K = 278 * MiB, WS_V = 295 * MiB;
constexpr size_t WS_SGA = 312 * MiB, WS_U = 378 * MiB, WS_SGB = 444 * MiB;
constexpr size_t WS_YPRE = WS_SGA;
static_assert(WS_U == WS_SGA + (size_t)66 * MiB && WS_SGB == WS_U + (size_t)66 * MiB, "YPRE overlay");
constexpr size_t WS_SMG = 510 * MiB;
constexpr size_t WS_A2 = 774 * MiB;
constexpr size_t WS_UH = 840 * MiB;
constexpr size_t WS_ZROW = 842 * MiB;
constexpr size_t WS_UX = 842 * MiB + 65536;
constexpr size_t WS_HG = 4 * MiB;
constexpr size_t WS_A1 = 843 * MiB;
constexpr size_t WS_W8 = 881 * MiB;
constexpr size_t WS_H8 = 902 * MiB;
constexpr size_t WS_END = 973 * MiB;
static_assert(WS_A1 + (size_t)M * PK_A12 <= WS_W8 && WS_W8 + (size_t)IN_DIM * PK_W8 <= WS_H8 && WS_H8 + (size_t)M * PK_H8 <= WS_END && WS_A2 + (size_t)M * PK_A12 <= WS_UH, "ws map 4");
static_assert(WS_WA + (size_t)DM * PK_WAB <= WS_WB && WS_WB + (size_t)DM * PK_WAB <= WS_WO && WS_WO + (size_t)DM * PK_WO <= WS_H, "ws map 5");
static_assert(WS_RSS + (size_t)M * 64 * 4 <= WS_WIN && WS_PART + (size_t)KS_ADA * NMOD * MOD_N * 4 <= WS_WIN && WS_WIN + (size_t)IN_DIM * DM * 2 <= WS_WA, "ws map 1");
static_assert(WS_H + (size_t)M * DM * 2 <= WS_Q && WS_Q + (size_t)M * NQ * 2 <= WS_K && WS_K + (size_t)M * NKV * 2 <= WS_V && WS_V + (size_t)M * NKV * 2 <= WS_SGA, "ws map 2");
static_assert(WS_SMG + (size_t)M * NMG * 2 <= WS_A2 && WS_A2 + (size_t)M * CD * 2 <= WS_UH, "ws map 3");
constexpr int CW_TMO = 0, CW_CODE = 1, CW_BAR = 4096;

constexpr int RING_OFF = 0, RING_BYTES = 131072;
constexpr int LDSCTL_OFF = 144384, MISC_OFF = LDSCTL_OFF + 320;
constexpr int LDS_BYTES = 147456;
constexpr int NWAVES = 8;

#define LDS_WAIT() asm volatile("s_waitcnt lgkmcnt(0)" ::: "memory")
#define VM_WAIT() asm volatile("s_waitcnt vmcnt(0)" ::: "memory")
__device__ __forceinline__ unsigned cvt_pk_bf16(float lo, float hi) { unsigned r; asm volatile("v_cvt_pk_bf16_f32 %0, %1, %2" : "=v"(r) : "v"(lo), "v"(hi)); return r; }
__device__ __forceinline__ float bf_lo(unsigned u) { return __uint_as_float(u << 16); }
__device__ __forceinline__ float bf_hi(unsigned u) { return __uint_as_float(u & 0xffff0000u); }
__device__ __forceinline__ float fast_sigmoid(float x) { return __builtin_amdgcn_rcpf(1.0f + __builtin_amdgcn_exp2f(-LOG2E * x)); }
__device__ __forceinline__ u32x4 pack8(f32x4 a, f32x4 b) { u32x4 w; w.x = cvt_pk_bf16(a[0], a[1]); w.y = cvt_pk_bf16(a[2], a[3]); w.z = cvt_pk_bf16(b[0], b[1]); w.w = cvt_pk_bf16(b[2], b[3]); return w; }
__device__ __forceinline__ float sat8(float x) { return __builtin_amdgcn_fmed3f(x, -448.0f, 448.0f); }
__device__ __forceinline__ int cvt2_fp8(float a, float b, int old, bool hi) { return hi ? __builtin_amdgcn_cvt_pk_fp8_f32(sat8(a), sat8(b), old, true) : __builtin_amdgcn_cvt_pk_fp8_f32(sat8(a), sat8(b), old, false); }
__device__ __forceinline__ u32x2 pack8_fp8(f32x4 a, f32x4 b) { int w0 = cvt2_fp8(a[0], a[1], 0, false); w0 = cvt2_fp8(a[2], a[3], w0, true);
    int w1 = cvt2_fp8(b[0], b[1], 0, false); w1 = cvt2_fp8(b[2], b[3], w1, true); u32x2 r; r.x = (unsigned)w0; r.y = (unsigned)w1; return r; }
__device__ __forceinline__ float wave_sum(float v) {
#pragma unroll
    for (int o = 1; o < 64; o <<= 1) v += __shfl_xor(v, o);
    return v;
}

namespace pg8 {
constexpr int BM = 256, BK = 64, HALF = 128, HTB = HALF * BK * 2, STAGE_BYTES = 8 * HTB, NXCD = 8, WGM = 8;
__host__ __device__ __forceinline__ int lds_byte(int r, int c) { const int st = (r >> 4) * 2 + (c >> 5), rr = r & 15, cc = c & 31, ob = rr * 64 + cc * 2; return st * 1024 + (ob ^ (((ob >> 9) & 1) << 5)); }
__host__ __device__ __forceinline__ void stage_rc(int b, int& R, int& C) { const int st = b / 1024, sb = b % 1024, swz = sb ^ (((sb >> 9) & 1) << 5); R = (st >> 1) * 16 + swz / 64; C = (st & 1) * 32 + (swz % 64) / 2; }
__host__ __device__ __forceinline__ int perm32(int rho) { const int n = rho >> 4, i = rho & 15; return 8 * (i >> 2) + 4 * n + (i & 3); }

__host__ __device__ __forceinline__ int lds_byte8(int r, int cb) { const int st = (r >> 4) * 2 + (cb >> 6), ob = (r & 15) * 64 + (cb & 63); return st * 1024 + (ob ^ (((ob >> 9) & 1) << 4)); }
__host__ __device__ __forceinline__ void stage_rc8(int b, int& R, int& CB) { const int st = b / 1024, sb = b % 1024, swz = sb ^ (((sb >> 9) & 1) << 4); R = (st >> 1) * 16 + swz / 64; CB = (st & 1) * 64 + swz % 64; }
struct Unit { int pm, pn, sel, qm; };
struct Gemm { const void* A0; const void* A1; const void* B0; const void* B1; int K; int pitchA = 0, pitchB = 0; };

struct Order {
    int nM, nN, nwg, G, c, pair, vcu, qtail, wgm, pmode = 0, nM2 = 0, nN2 = 0, nM3 = 0, nN3 = 0, cut = 0, nb = 0;
    __device__ __forceinline__ void init(int M_, int N_, int G_, int c_, int pair_, int vcu_, int qtail_, int wgm_) { wgm = wgm_; nM = M_ / BM; nN = N_ / BM; nwg = nM * nN; G = G_; c = c_; pair = pair_; vcu = vcu_;
        qtail = (qtail_ && (nwg % G_) != 0 && (nwg % G_) * 4 <= G_) ? 1 : 0; }
    __device__ __forceinline__ void init_inproj(int mode, int G_, int c_, int vcu_, int wgm_, int nb_) { wgm = wgm_; G = G_; c = c_; pair = 0; vcu = vcu_; qtail = 0; pmode = mode;
        nM = 8; nN = mode == 3 ? 2 : 36; nM2 = 4; nN2 = mode == 3 ? 10 : 28; nM3 = mode == 3 ? 1 : 120; nN3 = mode == 3 ? 8 : 38; nwg = nM * nN + nM2 * nN2 + nM3 * nN3;
        nb = nb_; cut = 0; if (nb_ > 0) { const int rest = nwg - 2 * (G_ - nb_); cut = rest > 0 ? (rest + G_ - 1) / G_ : 0; } }
    __device__ __forceinline__ bool next(int i, Unit& u) const {
        const int ii = pair ? (i >> 1) : i;
        long L = (long)ii * G + c; u.qm = 15;
        if (nb > 0 && ii >= cut) { if (c < nb) return false; L = (long)cut * G + (long)(ii - cut) * (G - nb) + (c - nb); }
        if (qtail && ii == nwg / G) { L = (long)ii * G + (vcu >> 2); u.qm = 1 << (vcu & 3); if ((vcu >> 2) >= nwg % G) return false; }
        if (L >= nwg) return false;
        asm volatile("" : "+s"(u.qm));
        int wgid = (int)L; { const int q = nwg / NXCD, r = nwg % NXCD, xcd = wgid % NXCD, off = wgid / NXCD; wgid = (xcd < r ? xcd * (q + 1) : r * (q + 1) + (xcd - r) * q) + off; }
        int rM = nM, rN = nN, rect = 0;
        if (pmode >= 3 && wgid >= nM * nN) { wgid -= nM * nN; rM = nM2; rN = nN2; rect = 1; if (wgid >= nM2 * nN2) { wgid -= nM2 * nN2; rM = nM3; rN = nN3; rect = 2; } }
        const int nig = wgm * rN, gid = wgid / nig, fm = gid * wgm, gsz = (rM - fm) < wgm ? (rM - fm) : wgm;
        int pm = fm + ((wgid % nig) % gsz), pn = (wgid % nig) / gsz;
        u.sel = pair ? (i & 1) : 0;
        if (pmode == 3) {
            if (rect == 0) { pm = 16 * pm + 15; pn += 4; } else if (rect == 1) { pm += 128; pn = pn < 2 ? 4 + pn : 8 + pn; } else { pn += 10; u.sel = 1; }
        } else if (pmode == 4) {
            if (rect == 0) { pm = 16 * pm + 15; pn = pn < 4 ? pn : 2 + pn; } else if (rect == 1) { pm += 128; pn = pn < 4 ? pn : (pn < 8 ? 2 + pn : 10 + pn); } else pm += pm / 15;
        }
        u.pm = pm; u.pn = pn;
        return true;
    }
};

template <class Epi, bool ALIGN_EPI, bool SP2, bool FP8 = false>
__device__ __forceinline__ void gemm_phase(LAS unsigned char* lds, const Gemm g, const Order& S, const Epi& E) {
    const int tid = threadIdx.x, wid = __builtin_amdgcn_readfirstlane(tid >> 6), lane = tid & 63, wr = wid >> 2, wc = wid & 3, fr = lane & 15, fq = lane >> 4;
    const int K = g.K, PB = FP8 ? K : 2 * K, nt = PB / 128; const int KPA = (FP8 && g.pitchA) ? g.pitchA : K, KPB = (FP8 && g.pitchB) ? g.pitchB : K;
    unsigned voffA[2], voffB[2];
#pragma unroll
    for (int i = 0; i < 2; ++i) { int R, C; if constexpr (FP8) { stage_rc8(tid * 16 + i * 8192, R, C); } else { stage_rc(tid * 16 + i * 8192, R, C); }
        const int Rb = Epi::PERM ? ((R & ~31) + perm32(R & 31)) : R;
        if constexpr (FP8) { voffA[i] = (unsigned)(R * KPA + C); voffB[i] = (unsigned)(Rb * KPB + C); } else { voffA[i] = (unsigned)(R * K + C) * 2u; voffB[i] = (unsigned)(Rb * K + C) * 2u; } }
    const size_t kstep = (size_t)128;
    const size_t hstepA = (size_t)HALF * (FP8 ? KPA : PB), hstepB = (size_t)HALF * (FP8 ? KPB : PB);
    const size_t tstepA = 2 * hstepA, tstepB = 2 * hstepB;
    const unsigned ldsw = (unsigned)wid * 1024u;
    const int aoff = FP8 ? lds_byte8(wr * 64 + fr, fq * 32) : lds_byte(wr * 64 + fr, fq * 8), boff = FP8 ? lds_byte8(wc * 32 + fr, fq * 32) : lds_byte(wc * 32 + fr, fq * 8);
    const int aoff1 = FP8 ? lds_byte8(wr * 64 + fr, fq * 32 + 16) : 0, boff1 = FP8 ? lds_byte8(wc * 32 + fr, fq * 32 + 16) : 0;
#define PG8_SA(b, h) (((b) * 2 + (h)) * HTB)
#define PG8_SB(b, h) ((4 + (b) * 2 + (h)) * HTB)
#define PG8_STAGE(bufoff, gbase, voff) do { _Pragma("unroll") for (int _i = 0; _i < 2; ++_i) \
        __builtin_amdgcn_global_load_lds((const unsigned*)((const char*)(gbase) + (voff)[_i]), (LAS unsigned*)(lds + (bufoff) + ldsw + _i * 8192), 16, 0, 0); } while (0)
#define PG8_LDA(dst, b, h) do { _Pragma("unroll") for (int m = 0; m < 4; ++m) _Pragma("unroll") for (int k = 0; k < 2; ++k) dst[m][k] = *(const LAS bf16x8*)(lds + PG8_SA(b, h) + (FP8 ? (k ? aoff1 : aoff) : aoff + k * 1024) + m * 2048); } while (0)
#define PG8_LDB(dst, b, h) do { _Pragma("unroll") for (int n = 0; n < 2; ++n) _Pragma("unroll") for (int k = 0; k < 2; ++k) dst[n][k] = *(const LAS bf16x8*)(lds + PG8_SB(b, h) + (FP8 ? (k ? boff1 : boff) : boff + k * 1024) + n * 2048); } while (0)
#define PG8_CAT8(x) __builtin_shufflevector(__builtin_bit_cast(i32x4, (x)[0]), __builtin_bit_cast(i32x4, (x)[1]), 0, 1, 2, 3, 4, 5, 6, 7)
#define PG8_MMA(ai, bj, At, Bt) do { if (!(cur.qm & (1 << (2 * (ai) + (bj))))) break; __builtin_amdgcn_s_setprio(1); _Pragma("unroll") for (int m = 0; m < 4; ++m) _Pragma("unroll") for (int n = 0; n < 2; ++n) { \
        if constexpr (FP8) acc[ai][bj][m][n] = __builtin_amdgcn_mfma_scale_f32_16x16x128_f8f6f4(PG8_CAT8(Bt[n]), PG8_CAT8(At[m]), acc[ai][bj][m][n], 0, 0, 0, 0x7F7F7F7F, 0, 0x7F7F7F7F); \
        else { _Pragma("unroll") for (int k = 0; k < 2; ++k) acc[ai][bj][m][n] = __builtin_amdgcn_mfma_f32_16x16x32_bf16(Bt[n][k], At[m][k], acc[ai][bj][m][n], 0, 0, 0); } } __builtin_amdgcn_s_setprio(0); } while (0)
#define PG8_WAIT_V(n) asm volatile("s_waitcnt vmcnt(" #n ")" ::: "memory")
#define PG8_WAIT_L(n) asm volatile("s_waitcnt lgkmcnt(" #n ")" ::: "memory")
#define PG8_WAIT_V8X(first) do { if ((first) && nepi >= 46) PG8_WAIT_V(54); else if ((first) && nepi >= 30) PG8_WAIT_V(38); else if ((first) && nepi >= 14) PG8_WAIT_V(22); else if ((first) && nepi >= 6) PG8_WAIT_V(14); else PG8_WAIT_V(8); } while (0)
#define PG8_BAR __builtin_amdgcn_s_barrier()
#define PG8_SCHED __builtin_amdgcn_sched_barrier(0)
    Unit cur, nxt; int ui = 0, nepi = 0;
    if (!S.next(0, cur)) return;
    f32x4 acc[2][2][4][2];
#pragma unroll
    for (int a = 0; a < 2; ++a)
#pragma unroll
        for (int b = 0; b < 2; ++b)
#pragma unroll
            for (int m = 0; m < 4; ++m)
#pragma unroll
                for (int n = 0; n < 2; ++n) acc[a][b][m][n] = (f32x4){0.f, 0.f, 0.f, 0.f};
    bf16x8 At[4][2], B0[2][2], B1[2][2];
    const char* cA = (const char*)(cur.sel ? g.A1 : g.A0) + (size_t)cur.pm * tstepA; const char* cB = (const char*)(cur.sel ? g.B1 : g.B0) + (size_t)cur.pn * tstepB;
    if constexpr (SP2) {
        PG8_STAGE(PG8_SB(0, 0), cB, voffB); PG8_STAGE(PG8_SB(0, 1), cB + hstepB, voffB); PG8_STAGE(PG8_SA(0, 0), cA, voffA); PG8_STAGE(PG8_SA(0, 1), cA + hstepA, voffA);
        if (wr == 1) PG8_BAR;
        PG8_WAIT_V(2); PG8_BAR;
        PG8_STAGE(PG8_SB(1, 0), cB + kstep, voffB); PG8_STAGE(PG8_SA(1, 0), cA + kstep, voffA); PG8_STAGE(PG8_SB(1, 1), cB + hstepB + kstep, voffB);
        PG8_WAIT_V(6); PG8_BAR;
    } else {
        PG8_STAGE(PG8_SB(0, 0), cB, voffB); PG8_STAGE(PG8_SA(0, 0), cA, voffA); PG8_STAGE(PG8_SB(0, 1), cB + hstepB, voffB); PG8_STAGE(PG8_SA(0, 1), cA + hstepA, voffA);
        if (wr == 1) PG8_BAR;
        PG8_WAIT_V(4); PG8_BAR;
        PG8_STAGE(PG8_SB(1, 0), cB + kstep, voffB); PG8_STAGE(PG8_SA(1, 0), cA + kstep, voffA); PG8_STAGE(PG8_SB(1, 1), cB + hstepB + kstep, voffB);
        PG8_WAIT_V(6); PG8_BAR;
    }
    for (;;) {
        const bool has_next = S.next(ui + 1, nxt);
        const char* nA = has_next ? (const char*)(nxt.sel ? g.A1 : g.A0) + (size_t)nxt.pm * tstepA : cA; const char* nB = has_next ? (const char*)(nxt.sel ? g.B1 : g.B0) + (size_t)nxt.pn * tstepB : cB;
        for (int t = 0; t < nt; t += 2) {
            const bool last = (t == nt - 2);
            const char* a1 = cA + (size_t)(t + 1) * kstep;
            const char* a2 = last ? nA : cA + (size_t)(t + 2) * kstep; const char* b2 = last ? nB : cB + (size_t)(t + 2) * kstep;
            const char* a3 = a2 + kstep; const char* b3 = b2 + kstep;
            if constexpr (SP2) {
            PG8_LDB(B0, 0, 0); PG8_LDB(B1, 0, 1); PG8_SCHED; PG8_LDA(At, 0, 0); PG8_STAGE(PG8_SA(1, 1), a1 + hstepA, voffA);
            PG8_WAIT_V8X(t == 0); PG8_WAIT_L(0); PG8_BAR; PG8_MMA(0, 0, At, B0); PG8_MMA(0, 1, At, B1); PG8_BAR; PG8_SCHED;
            PG8_LDA(At, 0, 1); PG8_STAGE(PG8_SB(0, 0), b2, voffB); PG8_STAGE(PG8_SB(0, 1), b2 + hstepB, voffB); PG8_STAGE(PG8_SA(0, 0), a2, voffA);
            PG8_WAIT_V8X(t == 0); PG8_WAIT_L(0); PG8_BAR; PG8_MMA(1, 0, At, B0); PG8_MMA(1, 1, At, B1); PG8_BAR; PG8_SCHED;
            PG8_LDB(B0, 1, 0); PG8_LDB(B1, 1, 1); PG8_SCHED; PG8_LDA(At, 1, 0); PG8_STAGE(PG8_SA(0, 1), a2 + hstepA, voffA);
            PG8_WAIT_V(8); PG8_WAIT_L(0); PG8_BAR; PG8_MMA(0, 0, At, B0); PG8_MMA(0, 1, At, B1); PG8_BAR; PG8_SCHED;
            PG8_LDA(At, 1, 1); PG8_STAGE(PG8_SB(1, 0), b3, voffB); PG8_STAGE(PG8_SB(1, 1), b3 + hstepB, voffB); PG8_STAGE(PG8_SA(1, 0), a3, voffA);
            PG8_WAIT_V(8); PG8_WAIT_L(0); PG8_BAR; PG8_MMA(1, 0, At, B0); PG8_MMA(1, 1, At, B1); PG8_BAR; PG8_SCHED;
            } else {
            PG8_LDB(B0, 0, 0); PG8_SCHED; PG8_LDA(At, 0, 0); PG8_STAGE(PG8_SA(1, 1), a1 + hstepA, voffA);
            PG8_WAIT_L(8); PG8_BAR; PG8_WAIT_L(0); PG8_MMA(0, 0, At, B0); PG8_BAR; PG8_SCHED;
            PG8_LDB(B1, 0, 1); PG8_STAGE(PG8_SB(0, 0), b2, voffB);
            PG8_BAR; PG8_WAIT_L(0); PG8_MMA(0, 1, At, B1); PG8_BAR;
            PG8_LDA(At, 0, 1); PG8_STAGE(PG8_SA(0, 0), a2, voffA);
            PG8_BAR; PG8_WAIT_L(0); PG8_MMA(1, 0, At, B0); PG8_BAR; PG8_SCHED;
            PG8_STAGE(PG8_SB(0, 1), b2 + hstepB, voffB);
            PG8_WAIT_V(6); PG8_BAR; PG8_MMA(1, 1, At, B1); PG8_BAR;
            PG8_LDB(B0, 1, 0); PG8_SCHED; PG8_LDA(At, 1, 0); PG8_STAGE(PG8_SA(0, 1), a2 + hstepA, voffA);
            PG8_WAIT_L(8); PG8_BAR; PG8_WAIT_L(0); PG8_MMA(0, 0, At, B0); PG8_BAR; PG8_SCHED;
            PG8_LDB(B1, 1, 1); PG8_STAGE(PG8_SB(1, 0), b3, voffB);
            PG8_BAR; PG8_WAIT_L(0); PG8_MMA(0, 1, At, B1); PG8_BAR;
            PG8_LDA(At, 1, 1); PG8_STAGE(PG8_SA(1, 0), a3, voffA);
            PG8_BAR; PG8_WAIT_L(0); PG8_MMA(1, 0, At, B0); PG8_BAR; PG8_SCHED;
            PG8_STAGE(PG8_SB(1, 1), b3 + hstepB, voffB);
            PG8_WAIT_V(6); PG8_BAR; PG8_MMA(1, 1, At, B1); PG8_BAR;
            }
        }
        if constexpr (ALIGN_EPI) { if (wr == 0) PG8_BAR; }
        const bool keep = E(acc, cur, wr, wc, fr, fq); nepi = Epi::nvm(cur);
        if (!has_next) break;
        if (!keep) {
#pragma unroll
        for (int a = 0; a < 2; ++a)
#pragma unroll
            for (int b = 0; b < 2; ++b)
#pragma unroll
                for (int m = 0; m < 4; ++m)
#pragma unroll
                    for (int n = 0; n < 2; ++n) acc[a][b][m][n] = (f32x4){0.f, 0.f, 0.f, 0.f};
        }
        cur = nxt; cA = nA; cB = nB; ++ui;
        if constexpr (ALIGN_EPI) { if (wr == 1) PG8_BAR; }
    }
    PG8_WAIT_V(0);
    if constexpr (!ALIGN_EPI) { if (wr == 0) PG8_BAR; }
    PG8_BAR;
#undef PG8_SA
#undef PG8_SB
#undef PG8_STAGE
#undef PG8_LDA
#undef PG8_LDB
#undef PG8_MMA
#undef PG8_CAT8
#undef PG8_WAIT_V
#undef PG8_WAIT_L
#undef PG8_WAIT_V8X
#undef PG8_BAR
#undef PG8_SCHED
}
}

template <bool F8> struct Epi1 {
    static constexpr bool PERM = true;
    bf16_t *Qb, *Kb, *Vb, *SGA, *U, *SGB, *SMG; const float* ropec; const float* ropes; bf16_t* UX;
    static constexpr float asc = F8 ? 1.0f / W8_SCALE : 1.0f;
    static __device__ __forceinline__ int nvm(const pg8::Unit& u) { return (u.pn >= 10 && u.pn < 18) ? 6 : 14; }
    __device__ __forceinline__ bool operator()(f32x4 (&acc)[2][2][4][2], const pg8::Unit& u, int wr, int wc, int fr, int fq) const {
        const int pn = u.pn, pm = u.pm;
        int rt = wr * 64 + fr;
        asm volatile("" : "+v"(rt));
        if (F8 ? pn < 5 : pn == 4) {
            const bool isq = pn < 4;
            const int head = isq ? (4 * pn + wc) : wc;
            const int ldc = isq ? NQ : NKV; const float sc = (isq ? QSCALE : 1.0f) * asc;
            GAS bf16_t* st = (GAS bf16_t*)(isq ? Qb : Kb) + ((size_t)pm * 256 + rt) * ldc + head * 64 + 8 * fq;
            const bool samp = pm >= 128;
            const GAS float* rc = (const GAS float*)ropec + (size_t)(samp ? PAST + fr : ((pm & 15) << 8) + rt) * 32 + 8 * fq;
            const GAS float* rs = (const GAS float*)ropes + (size_t)(samp ? PAST + fr : ((pm & 15) << 8) + rt) * 32 + 8 * fq;
            const int tstep = samp ? 0 : 1;
            f32x4 cs[2][4];
#define EPI1_LOAD(g, buf) do { const int o_ = samp ? ((g) & 1) * 16 * 32 : 0; cs[buf][0] = *(const GAS f32x4*)(rc + o_); cs[buf][1] = *(const GAS f32x4*)(rc + o_ + 4); cs[buf][2] = *(const GAS f32x4*)(rs + o_); cs[buf][3] = *(const GAS f32x4*)(rs + o_ + 4); \
            rc += tstep * (((g) & 3) == 3 ? 80 : 16) * 32; rs += tstep * (((g) & 3) == 3 ? 80 : 16) * 32; asm volatile("" : "+v"(rc), "+v"(rs)); } while (0)
            EPI1_LOAD(0, 0);
#pragma unroll
            for (int g = 0; g < 8; ++g) {
                if (g + 1 < 8) EPI1_LOAD(g + 1, (g + 1) & 1);
                const int ai = g >> 2, m = g & 3;
                const f32x4 c0 = cs[g & 1][0], c1 = cs[g & 1][1], s0 = cs[g & 1][2], s1 = cs[g & 1][3];
                const f32x4 x10 = acc[ai][0][m][0], x11 = acc[ai][0][m][1], x20 = acc[ai][1][m][0], x21 = acc[ai][1][m][1];
                const f32x4 o10 = (x10 * c0 - x20 * s0) * sc, o11 = (x11 * c1 - x21 * s1) * sc, o20 = (x20 * c0 + x10 * s0) * sc, o21 = (x21 * c1 + x11 * s1) * sc;
                *(GAS u32x4*)st = pack8(o10, o11); *(GAS u32x4*)(st + 32) = pack8(o20, o21);
                st += ((g & 3) == 3 ? 80 : 16) * ldc; asm volatile("" : "+v"(st));
            }
#undef EPI1_LOAD
        } else if (pn >= 10 && pn < 18) {
            GAS bf16_t* st = (GAS bf16_t*)((!F8 && u.sel) ? UX : U) + ((size_t)pm * 256 + rt) * CD + (pn - 10) * 128 + wc * 32 + 8 * fq;
#pragma unroll
            for (int g = 0; g < 8; ++g) {
                const int ai = g >> 2, m = g & 3;
                f32x4 v0 = acc[ai][0][m][0], v1 = acc[ai][0][m][1]; const f32x4 g0 = acc[ai][1][m][0], g1 = acc[ai][1][m][1];
#pragma unroll
                for (int i = 0; i < 4; ++i) { v0[i] *= asc * fast_sigmoid(g0[i] * asc); v1[i] *= asc * fast_sigmoid(g1[i] * asc); }
                *(GAS u32x4*)st = pack8(v0, v1);
                st += ((g & 3) == 3 ? 80 : 16) * CD; asm volatile("" : "+v"(st));
            }
        } else if (F8 && pn >= 22) {
            GAS bf16_t* st = (GAS bf16_t*)SMG + ((size_t)pm * 256 + rt) * DM + (pn - 22) * 128 + wc * 32 + 8 * fq;
            const float nl2 = -LOG2E * asc;
#pragma unroll
            for (int g = 0; g < 8; ++g) {
                const int ai = g >> 2, m = g & 3;
                f32x4 r0, r1, b0, b1; const f32x4 a0 = acc[ai][0][m][0], a1 = acc[ai][0][m][1], g0 = acc[ai][1][m][0], g1 = acc[ai][1][m][1];
#pragma unroll
                for (int i = 0; i < 4; ++i) {
                    const float ea0 = 1.0f + __builtin_amdgcn_exp2f(fminf(nl2 * a0[i], 40.f)), eb0 = 1.0f + __builtin_amdgcn_exp2f(fminf(nl2 * g0[i], 40.f));
                    const float ea1 = 1.0f + __builtin_amdgcn_exp2f(fminf(nl2 * a1[i], 40.f)), eb1 = 1.0f + __builtin_amdgcn_exp2f(fminf(nl2 * g1[i], 40.f));
                    b0[i] = __builtin_amdgcn_rcpf(eb0); r0[i] = eb0 * __builtin_amdgcn_rcpf(ea0); b1[i] = __builtin_amdgcn_rcpf(eb1); r1[i] = eb1 * __builtin_amdgcn_rcpf(ea1);
                }
                *(GAS u32x4*)st = pack8(r0, r1); *(GAS u32x4*)(st + (size_t)M * DM) = pack8(b0, b1);
                st += ((g & 3) == 3 ? 80 : 16) * DM; asm volatile("" : "+v"(st));
            }
        } else {
            bf16_t* d0; int ldc, ct, mode;
            if (!F8 || pn == 5) { d0 = Vb; ldc = NKV; ct = 0; mode = 0; }
            else if (pn < 10) { d0 = SGA; ldc = NQ; ct = pn - 6; mode = 1; }
            else { d0 = SGB; ldc = CD; ct = pn - 18; mode = 1; }
            GAS bf16_t* st = (GAS bf16_t*)d0 + ((size_t)pm * 256 + rt) * ldc + ct * 256 + wc * 32 + 8 * fq;
#pragma unroll
            for (int g = 0; g < 8; ++g) {
                const int ai = g >> 2, m = g & 3;
#pragma unroll
                for (int bj = 0; bj < 2; ++bj) {
                    f32x4 v0 = acc[ai][bj][m][0], v1 = acc[ai][bj][m][1];
                    v0 *= asc; v1 *= asc;
                    if (mode != 0) {
#pragma unroll
                        for (int i = 0; i < 4; ++i) { v0[i] *= fast_sigmoid(v0[i]); v1[i] *= fast_sigmoid(v1[i]); }
                    }
                    *(GAS u32x4*)(st + bj * 128) = pack8(v0, v1);
                }
                st += ((g & 3) == 3 ? 80 : 16) * ldc; asm volatile("" : "+v"(st));
            }
        }
        return false;
    }
};
struct Epi2 {
    static constexpr bool PERM = true;
    static __device__ __forceinline__ int nvm(const pg8::Unit& u) { return (u.sel != 0 && u.qm == 15) ? 30 : 14; }
    bf16_t* MG; const bf16_t* SMG;
    __device__ __forceinline__ bool operator()(f32x4 (&acc)[2][2][4][2], const pg8::Unit& u, int wr, int wc, int fr, int fq) const {
        const int rt = wr * 64 + fr; const int c0 = u.pn * 256 + wc * 32 + 8 * fq;
        const bool fin = u.sel != 0;
        const GAS bf16_t* ls = (const GAS bf16_t*)SMG + (fin ? (size_t)M * DM : 0) + ((size_t)u.pm * 256 + rt) * DM + c0;
        GAS unsigned char* st = (GAS unsigned char*)MG + ((size_t)u.pm * 256 + rt) * PK_MG + c0;
        constexpr int DEPTH = 4;
        u32x4 sg[DEPTH][2];
#define EPI2_LOAD(g, buf) do { sg[buf][0] = *(const GAS u32x4*)ls; sg[buf][1] = *(const GAS u32x4*)(ls + 128); ls += (((g) & 3) == 3 ? 80 : 16) * DM; asm volatile("" : "+v"(ls)); } while (0)
#pragma unroll
        for (int g = 0; g < DEPTH - 1; ++g) EPI2_LOAD(g, g);
#pragma unroll
        for (int g = 0; g < 8; ++g) {
            if (g + DEPTH - 1 < 8) EPI2_LOAD(g + DEPTH - 1, (g + DEPTH - 1) % DEPTH);
            const int ai = g >> 2, m = g & 3;
#pragma unroll
            for (int bj = 0; bj < 2; ++bj) {
                const u32x4 s4 = sg[g % DEPTH][bj];
                f32x4 v0 = acc[ai][bj][m][0], v1 = acc[ai][bj][m][1];
                v0[0] *= bf_lo(s4.x); v0[1] *= bf_hi(s4.x); v0[2] *= bf_lo(s4.y); v0[3] *= bf_hi(s4.y);
                v1[0] *= bf_lo(s4.z); v1[1] *= bf_hi(s4.z); v1[2] *= bf_lo(s4.w); v1[3] *= bf_hi(s4.w);
                if (fin) { if (u.qm & (1 << (2 * ai + bj))) *(GAS u32x2*)(st + bj * 128) = pack8_fp8(v0 * (MG8_SCALE / (A8_SCALE * W8_SCALE)), v1 * (MG8_SCALE / (A8_SCALE * W8_SCALE))); }
                else { acc[ai][bj][m][0] = v0; acc[ai][bj][m][1] = v1; }
            }
            st += ((g & 3) == 3 ? 80 : 16) * PK_MG; asm volatile("" : "+v"(st));
        }
#undef EPI2_LOAD
        return !fin;
    }
};
struct Epi3 {
    static constexpr bool PERM = true;
    static __device__ __forceinline__ int nvm(const pg8::Unit& u) { return u.qm == 15 ? 14 : 2; }
    const float* gate; bf16_t* ybr;
    __device__ __forceinline__ bool operator()(f32x4 (&acc)[2][2][4][2], const pg8::Unit& u, int wr, int wc, int fr, int fq) const {
        const int rt = wr * 64 + fr; const int c0 = u.pn * 256 + wc * 32 + 8 * fq;
        const bool samp = u.pm >= 128;
        const GAS float* gb = (const GAS float*)gate + (size_t)(samp ? NB_P + (u.pm - 128) * 8 + 2 * wr : (u.pm >> 4)) * DM + c0;
        GAS bf16_t* sy = (GAS bf16_t*)ybr + ((size_t)u.pm * 256 + rt) * DM + c0;
        f32x4 gv[4];
#define EPI3_GATE(g) do { const GAS float* gp_ = gb + (samp ? (4 * ((g) >> 2) + (((g) & 3) >> 1)) * DM : 0); _Pragma("unroll") for (int q_ = 0; q_ < 4; ++q_) gv[q_] = *(const GAS f32x4*)(gp_ + (q_ >> 1) * 128 + (q_ & 1) * 4) * (1.0f / (W8_SCALE * MG8_SCALE)); } while (0)
        EPI3_GATE(0);
#pragma unroll
        for (int g = 0; g < 8; ++g) {
            if (g > 0 && (g & 1) == 0 && samp) EPI3_GATE(g);
            const int ai = g >> 2, m = g & 3;
#pragma unroll
            for (int bj = 0; bj < 2; ++bj)
                if (u.qm & (1 << (2 * ai + bj))) *(GAS u32x4*)(sy + bj * 128) = pack8(gv[2 * bj] * acc[ai][bj][m][0], gv[2 * bj + 1] * acc[ai][bj][m][1]);
            sy += ((g & 3) == 3 ? 80 : 16) * DM; asm volatile("" : "+v"(sy));
        }
#undef EPI3_GATE
        return false;
    }
};

typedef GAS unsigned gu32;
#define RLX_AGENT __ATOMIC_RELAXED, __HIP_MEMORY_SCOPE_AGENT
#define XB_TMO      128
#define XB_XCNT(j)  (256  + 64 * (j))
#define XB_XSUB(j)  (1280 + 64 * (j))
#define XB_XGEN(j)  (2304 + 64 * (j))
#define XB_TOP      3328
#define XB_TOPGEN   3392
#define XCD_BAR_WORDS 3456
#define XB_SPIN_CAP (1u << 18)
__device__ __forceinline__ unsigned xb_ld(unsigned* p)              { return __hip_atomic_load(p, __ATOMIC_RELAXED, __HIP_MEMORY_SCOPE_AGENT); }
__device__ __forceinline__ unsigned xb_add(unsigned* p, unsigned v) { return __hip_atomic_fetch_add(p, v, __ATOMIC_RELAXED, __HIP_MEMORY_SCOPE_AGENT); }
__device__ __forceinline__ unsigned xb_xcc_id() { return (unsigned)__builtin_amdgcn_s_getreg((3 << 11) | 20) & 0xFu; }
#define XB_SPIN(cond, bar) do { unsigned _sp = 0; while (cond) { __builtin_amdgcn_s_sleep(1); \
    if ((++_sp & 255u) == 0u) { if (xb_ld(&(bar)[XB_TMO])) break; if (_sp > XB_SPIN_CAP) { atomicAdd(&(bar)[XB_TMO], 1u); break; } } } } while (0)
struct XcdBarrier { unsigned* bar; unsigned x; volatile LAS unsigned* st; };
__device__ __forceinline__ XcdBarrier xcd_barrier_post(unsigned* bar, volatile LAS unsigned* st) {
    XcdBarrier b; b.bar = bar; b.x = xb_xcc_id(); b.st = st;
    if (threadIdx.x == 0) (void)xb_add(&bar[XB_XCNT(b.x)], 1u);
    return b;
}
__device__ __forceinline__ void xcd_barrier_complete(unsigned* bar, unsigned x, unsigned& nloc, unsigned& nx) {
    const unsigned G = gridDim.x * gridDim.y * gridDim.z;
    unsigned sum, cnt, mine, sp = 0u;
    for (;;) {
        sum = 0u; cnt = 0u; mine = 0u;
#pragma unroll
        for (unsigned j = 0; j < 16; ++j) { const unsigned c = xb_ld(&bar[XB_XCNT(j)]); sum += c; cnt += (c > 0u) ? 1u : 0u; mine = (j == x) ? c : mine; }
        if (sum == G) break;
        __builtin_amdgcn_s_sleep(1);
        if ((++sp & 255u) == 0u) { if (xb_ld(&bar[XB_TMO])) break; if (sp > XB_SPIN_CAP) { atomicAdd(&bar[XB_TMO], 1u); break; } }
    }
    nloc = mine > 0u ? mine : 1u; nx = cnt > 0u ? cnt : 1u;
}
__device__ __forceinline__ void xcd_barrier(const XcdBarrier& b) {
    asm volatile("s_waitcnt vmcnt(0)" ::: "memory");
    __syncthreads();
    if (threadIdx.x == 0) {
        unsigned* bar = b.bar;
        __builtin_amdgcn_s_waitcnt(0);
        unsigned nloc = b.st[0], nx = b.st[1];
        if (nloc == 0u) { xcd_barrier_complete(bar, b.x, nloc, nx); b.st[0] = nloc; b.st[1] = nx; }
        const unsigned old = xb_add(&bar[XB_XSUB(b.x)], 1u);
        const unsigned gen = old / nloc;
        if (old + 1u == (gen + 1u) * nloc) {
            __builtin_amdgcn_fence(__ATOMIC_RELEASE, "agent");
            asm volatile("s_waitcnt vmcnt(0)" ::: "memory");
            const unsigned og = xb_add(&bar[XB_TOP], 1u);
            const unsigned tg = og / nx;
            if (og + 1u == (tg + 1u) * nx) xb_add(&bar[XB_TOPGEN], 1u);
            else XB_SPIN(xb_ld(&bar[XB_TOPGEN]) == tg, bar);
            __builtin_amdgcn_fence(__ATOMIC_ACQUIRE, "agent");
            xb_add(&bar[XB_XGEN(b.x)], 1u);
            asm volatile("s_waitcnt vmcnt(0)" ::: "memory");
        } else {
            XB_SPIN(xb_ld(&bar[XB_XGEN(b.x)]) == gen, bar);
            __builtin_amdgcn_fence(__ATOMIC_ACQUIRE, "agent");
            asm volatile("s_waitcnt vmcnt(0)" ::: "memory");
        }
    }
    __syncthreads();
}

struct Frame {
    LAS unsigned char* lds;
    int tid, lane, wave, vcu, G;
    const float *xp, *xs, *cp, *cs, *cache_k, *cache_v, *state_conv, *norm_g, *w_ada, *b_ada, *w_in, *sinks, *w_dw, *b_dw, *ln_g, *ln_b, *w_pa, *w_pb, *w_out, *final_g;
    float* out;
    float *gate, *ropec, *ropes, *rss, *part;
    unsigned char *W8, *H8;
    bf16_t *Win_t, *Wa_t, *Wb_t, *Wo_t, *H, *Qb, *Kb, *Vb, *SGA, *U, *SGB, *SMG, *A1, *A2, *UH, *ZROW, *UX, *HG;
};

__constant__ double INV_FREQ[32] = {1.0, 0.7498942093324559, 0.5623413251903491, 0.4216965034285822, 0.31622776601683794, 0.23713737056616552, 0.1778279410038923, 0.1333521432163324,
    0.1, 0.07498942093324558, 0.05623413251903491, 0.042169650342858224, 0.03162277660168379, 0.023713737056616554, 0.01778279410038923, 0.01333521432163324,
    0.01, 0.007498942093324558, 0.005623413251903491, 0.004216965034285823, 0.0031622776601683794, 0.0023713737056616554, 0.0017782794100389228, 0.001333521432163324,
    0.001, 0.0007498942093324559, 0.0005623413251903491, 0.00042169650342858224, 0.00031622776601683794, 0.00023713737056616554, 0.00017782794100389227, 0.0001333521432163324};

__host__ __device__ __forceinline__ bool tile_w8(int tile) { return true; }
__host__ __device__ __forceinline__ bool tile_wb(int tile) { return tile == 4 || tile == 5 || (tile >= 10 && tile < 18); }
__device__ __forceinline__ int colmap(int n) {
    const int tile = n >> 8, j = n & 255, bj = j >> 7, x = j & 127;
    if (tile < 4) return (4 * tile + (x >> 5)) * 64 + bj * 32 + (x & 31);
    if (tile == 4) return NQ + (x >> 5) * 64 + bj * 32 + (x & 31);
    if (tile >= 10 && tile < 18) return 2560 + bj * 1024 + 128 * (tile - 10) + x;
    if (tile >= 22) return 5632 + bj * DM + 128 * (tile - 22) + x;
    return n;
}
struct TrBlk { f32x4 a, b, c, d, e, f, g, h; };
__device__ __forceinline__ void tr_load(const float* W, int N, int k0, int n0s, int lane, TrBlk& v) {
    const GAS float* p = (const GAS float*)W + (size_t)(k0 + (lane >> 3)) * N + n0s + 4 * (lane & 7);
    v.a = *(const GAS f32x4*)p; v.b = *(const GAS f32x4*)(p + (size_t)8 * N); v.c = *(const GAS f32x4*)(p + (size_t)16 * N); v.d = *(const GAS f32x4*)(p + (size_t)24 * N);
    v.e = *(const GAS f32x4*)(p + (size_t)32 * N); v.f = *(const GAS f32x4*)(p + (size_t)40 * N); v.g = *(const GAS f32x4*)(p + (size_t)48 * N); v.h = *(const GAS f32x4*)(p + (size_t)56 * N);
}
__device__ __forceinline__ void tr_scatter(const TrBlk& v, LAS float* scr, int lane) {
    LAS float* q = scr + (lane >> 3) * 33 + 4 * (lane & 7);
#define TR_PUT(x, i) do { q[(8 * (i)) * 33] = (x)[0]; q[(8 * (i)) * 33 + 1] = (x)[1]; q[(8 * (i)) * 33 + 2] = (x)[2]; q[(8 * (i)) * 33 + 3] = (x)[3]; } while (0)
    TR_PUT(v.a, 0); TR_PUT(v.b, 1); TR_PUT(v.c, 2); TR_PUT(v.d, 3); TR_PUT(v.e, 4); TR_PUT(v.f, 5); TR_PUT(v.g, 6); TR_PUT(v.h, 7);
#undef TR_PUT
    LDS_WAIT(); asm volatile("" ::: "memory");
}
__device__ __forceinline__ void transpose_item(int K, bf16_t* WT, int k0, int n0d, LAS float* scr, int lane) {
    const int c = lane & 7;
#pragma unroll
    for (int j = 0; j < 4; ++j) { const int n = (lane >> 3) + 8 * j; const LAS float* s = scr + (8 * c) * 33 + n;
        u32x4 o; o.x = cvt_pk_bf16(s[0 * 33], s[1 * 33]); o.y = cvt_pk_bf16(s[2 * 33], s[3 * 33]); o.z = cvt_pk_bf16(s[4 * 33], s[5 * 33]); o.w = cvt_pk_bf16(s[6 * 33], s[7 * 33]);
        *(GAS u32x4*)(WT + (size_t)(n0d + n) * K + k0 + 8 * c) = o; }
    LDS_WAIT(); asm volatile("" ::: "memory");
}

__device__ __forceinline__ void transpose_item8(int KPITCH, unsigned char* WT, int k0, int n0d, float scale, LAS float* scr, int lane) {
#pragma unroll
    for (int j = 0; j < 2; ++j) { const int cid = lane + 64 * j, n = cid >> 2, c = cid & 3; const LAS float* sp = scr + (16 * c) * 33 + n;
        f32x4 a, b, c4, d;
#pragma unroll
        for (int i = 0; i < 4; ++i) { a[i] = sp[i * 33] * scale; b[i] = sp[(4 + i) * 33] * scale; c4[i] = sp[(8 + i) * 33] * scale; d[i] = sp[(12 + i) * 33] * scale; }
        const u32x2 lo = pack8_fp8(a, b), hi = pack8_fp8(c4, d);
        *(GAS u32x4*)(WT + (size_t)(n0d + n) * KPITCH + k0 + 16 * c) = (u32x4){lo.x, lo.y, hi.x, hi.y}; }
    LDS_WAIT(); asm volatile("" ::: "memory");
}

__device__ __forceinline__ void p0_prologue(Frame& F) {
    LAS float* scr = (LAS float*)(F.lds + RING_OFF + F.wave * 16384);
    const int gw = F.vcu * NWAVES + F.wave, NGW = F.G * NWAVES, lane = F.lane;
    {
        const int n31 = lane & 31, kh = lane >> 5;
        for (int it = gw; it < KS_ADA * (MOD_N / 32); it += NGW) {
            const int ks = it / (MOD_N / 32), nb = it % (MOD_N / 32), n = nb * 32 + n31;
            f32x16 acc0, acc1;
#pragma unroll
            for (int r = 0; r < 16; ++r) { acc0[r] = 0.f; acc1[r] = 0.f; }
            constexpr int NHF = DM / KS_ADA / 64;
            static_assert(NHF % 2 == 0, "adaLN k chunks come in pairs");
            float wb[NHF][32], cv[NMOD];
            const GAS float* wp = (const GAS float*)F.w_ada + (size_t)(ks * (DM / KS_ADA) + 8 * kh) * MOD_N + n;
            const GAS float* cpp_ = (const GAS float*)F.cp + ks * (DM / KS_ADA) + lane; const GAS float* csp_ = (const GAS float*)F.cs + ks * (DM / KS_ADA) + lane;
#define ADA_LOADW(buf_) do { _Pragma("unroll") for (int kp_ = 0; kp_ < 32; ++kp_) { wb[buf_][kp_] = *wp; wp += ((kp_ & 7) == 7 ? 9 : 1) * MOD_N; asm volatile("" : "+v"(wp)); } } while (0)
#define ADA_LOADC() do { _Pragma("unroll") for (int r_ = 0; r_ < NMOD; ++r_) cv[r_] = (r_ < NB_P) ? cpp_[r_ * DM] : csp_[(r_ - NB_P) * DM]; cpp_ += 64; csp_ += 64; asm volatile("" : "+v"(cpp_), "+v"(csp_)); } while (0)
#define ADA_STAGE() do { _Pragma("unroll") for (int r_ = 0; r_ < NMOD; ++r_) scr[lane * 41 + r_] = cv[r_] * fast_sigmoid(cv[r_]); LDS_WAIT(); asm volatile("" ::: "memory"); } while (0)
#define ADA_MMA(buf_) do { _Pragma("unroll") for (int s_ = 0; s_ < 4; ++s_) { u32x4 a0_, a1_, b_; \
                    _Pragma("unroll") for (int i_ = 0; i_ < 4; ++i_) { const LAS float* sp_ = scr + (16 * s_ + 8 * kh + 2 * i_) * 41 + n31; \
                        a0_[i_] = cvt_pk_bf16(sp_[0], sp_[41]); a1_[i_] = n31 < 8 ? cvt_pk_bf16(sp_[32], sp_[41 + 32]) : 0u; b_[i_] = cvt_pk_bf16(wb[buf_][8 * s_ + 2 * i_], wb[buf_][8 * s_ + 2 * i_ + 1]); } \
                    acc0 = __builtin_amdgcn_mfma_f32_32x32x16_bf16(__builtin_bit_cast(bf16x8, a0_), __builtin_bit_cast(bf16x8, b_), acc0, 0, 0, 0); \
                    acc1 = __builtin_amdgcn_mfma_f32_32x32x16_bf16(__builtin_bit_cast(bf16x8, a1_), __builtin_bit_cast(bf16x8, b_), acc1, 0, 0, 0); } \
                LDS_WAIT(); asm volatile("" ::: "memory"); } while (0)
            ADA_LOADC();
#pragma unroll
            for (int hf = 0; hf < NHF; ++hf) ADA_LOADW(hf);
#pragma unroll
            for (int hf = 0; hf < NHF; ++hf) { ADA_STAGE(); if (hf + 1 < NHF) ADA_LOADC(); ADA_MMA(hf); }
#undef ADA_LOADW
#undef ADA_LOADC
#undef ADA_STAGE
#undef ADA_MMA
            GAS float* pp = (GAS float*)F.part + (size_t)ks * NMOD * MOD_N + n;
#pragma unroll
            for (int r = 0; r < 16; ++r) pp[(size_t)((r & 3) + 8 * (r >> 2) + 4 * kh) * MOD_N] = acc0[r];
#pragma unroll
            for (int r = 0; r < 4; ++r) pp[(size_t)(32 + r + 4 * kh) * MOD_N] = acc1[r];
        }
    }
}


__device__ __forceinline__ void p2_fill(Frame& F, int idx, int nfill) {
    LAS float* scr = (LAS float*)(F.lds + RING_OFF + F.wave * 16384);
    const int gw = idx * NWAVES + F.wave, NGW = nfill * NWAVES, lane = F.lane, tid = F.tid;
    constexpr int I_PA = (NQ / 64) * (DM / 32), I_PB = (CD / 64) * (DM / 32), I_WO = (DM / 64) * (DM / 32);
    {
        TrBlk v;
        const float* wpa_ = F.w_pa; const float* wpb_ = F.w_pb; const float* wo_ = F.w_out; asm volatile("" : "+s"(wpa_), "+s"(wpb_), "+s"(wo_));
#define P2F_SRC(it) ((it) < I_PA ? wpa_ : ((it) < I_PA + I_PB ? wpb_ : wo_))
#define P2F_REL(it) ((it) < I_PA ? (it) : ((it) < I_PA + I_PB ? (it) - I_PA : (it) - I_PA - I_PB))
        int it = gw; bool have = it < I_PA + I_PB + I_WO;
        if (have) { const int r = P2F_REL(it); tr_load(P2F_SRC(it), DM, 64 * (r / (DM / 32)), 32 * (r % (DM / 32)), lane, v); }
        while (have) {
            const int cur = it; it += NGW;
            tr_scatter(v, scr, lane);
            const bool nxt = it < I_PA + I_PB + I_WO;
            if (nxt) { const int r = P2F_REL(it); tr_load(P2F_SRC(it), DM, 64 * (r / (DM / 32)), 32 * (r % (DM / 32)), lane, v); }
            const int r = P2F_REL(cur), kb = r / (DM / 32), nb = r % (DM / 32);
            if (cur < I_PA) transpose_item8(PK_WAB, (unsigned char*)F.Wa_t, 64 * kb, 32 * nb, W8_SCALE, scr, lane);
            else if (cur < I_PA + I_PB) transpose_item8(PK_WAB, (unsigned char*)F.Wb_t, 64 * kb, 32 * nb, W8_SCALE, scr, lane);
            else transpose_item8(PK_WO, (unsigned char*)F.Wo_t, 64 * kb, 32 * nb, W8_SCALE, scr, lane);
            have = nxt;
        }
    }
    for (int bi = idx; bi < NMOD; bi += nfill) {
        const int k = 4 * tid;
        f32x4 a = *(const GAS f32x4*)(F.b_ada + 2 * DM + k);
#pragma unroll
        for (int ks = 0; ks < KS_ADA; ++ks) a += *(const GAS f32x4*)(F.part + ((size_t)ks * NMOD + bi) * MOD_N + 2 * DM + k);
        *(GAS f32x4*)(F.gate + (size_t)bi * DM + k) = a;
    }
    const int gt = idx * (NWAVES * 64) + tid, NGT = nfill * NWAVES * 64;
    for (int e = gt; e < 2 * NB_S * 96 * (NKV / 4); e += NGT) {
        const int which = e / (NB_S * 96 * (NKV / 4)), r = e % (NB_S * 96 * (NKV / 4)), b = r / (96 * (NKV / 4)), q = r % (96 * (NKV / 4));
        const float* src = (which ? F.cache_v : F.cache_k) + ((size_t)b * WIN + 32) * NKV + (size_t)q * 4;
        float* dst = F.out + (which ? OV_S : OK_S) + (size_t)b * WIN * NKV + (size_t)q * 4;
        *(GAS f32x4*)dst = *(const GAS f32x4*)src;
    }
    for (int e = gt; e < NB_S * HIST * CD / 4; e += NGT) { const f32x4 v = *(const GAS f32x4*)(F.state_conv + (size_t)e * 4); u32x2 w; w.x = cvt_pk_bf16(v[0], v[1]); w.y = cvt_pk_bf16(v[2], v[3]); *(GAS u32x2*)(F.UH + (size_t)e * 4) = w; }
    if (gt < CD / 2) *(GAS unsigned*)(F.ZROW + 2 * gt) = 0u;
}

__device__ __forceinline__ void p1_weights(Frame& F) {
    LAS float* scr = (LAS float*)(F.lds + RING_OFF + F.wave * 16384);
    const int gw = F.vcu * NWAVES + F.wave, NGW = F.G * NWAVES, lane = F.lane;
    constexpr int I_IN = (DM / 64) * (IN_DIM / 32);
    {
        constexpr int nblk = IN_DIM / 32;
        TrBlk v;
        int it = gw; bool have = it < I_IN;
        if (have) tr_load(F.w_in, IN_DIM, 64 * (it / nblk), colmap(32 * (it % nblk)), lane, v);
        while (have) {
            const int cur = it; it += NGW;
            tr_scatter(v, scr, lane);
            const bool nxt = it < I_IN;
            if (nxt) tr_load(F.w_in, IN_DIM, 64 * (it / nblk), colmap(32 * (it % nblk)), lane, v);
            const int kb = cur / nblk, nb = cur % nblk;
            if (tile_w8(nb >> 3)) transpose_item8(PK_W8, F.W8, 64 * kb, 32 * nb, W8_SCALE, scr, lane);
            if (tile_wb(nb >> 3)) transpose_item(DM, F.Win_t, 64 * kb, 32 * nb, scr, lane);
            have = nxt;
        }
    }
    const int gt = F.vcu * (NWAVES * 64) + F.tid, NGT = F.G * NWAVES * 64;
    for (int e = gt; e < SEQ * 32; e += NGT) {
        const int pos = e >> 5, d = e & 31;
        const double rev = (double)pos * INV_FREQ[d] * 0.15915494309189535;
        const float fr = (float)(rev - __builtin_floor(rev));
        *(GAS float*)(F.ropec + e) = __builtin_amdgcn_cosf(fr); *(GAS float*)(F.ropes + e) = __builtin_amdgcn_sinf(fr);
    }
}

__device__ __forceinline__ void p1_hrows(Frame& F) {
    LAS float* gs = (LAS float*)(F.lds + RING_OFF); LAS float* sh = gs + DM;
    const int tid = F.tid, lane = F.lane;
    constexpr int NU_P = MP / 64, NU = NU_P + NB_S;
    for (int it = F.vcu; it < NU; it += F.G) {
        const bool samp = it >= NU_P;
        const int bi = samp ? NB_P + (it - NU_P) : (it >> 6);
        const int nrows = samp ? 32 : 64;
        const bool outp = samp || ((it >> 2) & 15) == 15;
        const size_t row0 = samp ? (size_t)MP + (size_t)(it - NU_P) * 32 : (size_t)it * 64;
        const float* x0 = samp ? F.xs + (size_t)(it - NU_P) * 32 * DM : F.xp + (size_t)it * 64 * DM;
        __syncthreads();
        { const int k = 4 * tid;
          f32x4 s0 = *(const GAS f32x4*)(F.b_ada + k), s1 = *(const GAS f32x4*)(F.b_ada + DM + k);
#pragma unroll
          for (int ks = 0; ks < KS_ADA; ++ks) { const float* p = F.part + ((size_t)ks * NMOD + bi) * MOD_N + k; s0 += *(const GAS f32x4*)p; s1 += *(const GAS f32x4*)(p + DM); }
          const f32x4 g = *(const GAS f32x4*)(F.norm_g + k);
          *(LAS f32x4*)(sh + k) = s0; *(LAS f32x4*)(gs + k) = g * (s1 + 1.0f); }
        __syncthreads();
        for (int r = F.wave; r < nrows; r += 2 * NWAVES) {
            const GAS f32x4* xr = (const GAS f32x4*)(x0 + (size_t)r * DM) + 2 * lane;
            f32x4 v[2][8]; float s[2] = {0.f, 0.f};
#pragma unroll
            for (int h = 0; h < 2; ++h)
#pragma unroll
                for (int j = 0; j < 4; ++j) { v[h][2 * j] = xr[h * NWAVES * (DM / 4) + 128 * j]; v[h][2 * j + 1] = xr[h * NWAVES * (DM / 4) + 128 * j + 1]; }
#pragma unroll
            for (int h = 0; h < 2; ++h)
#pragma unroll
                for (int j = 0; j < 8; ++j) s[h] += (v[h][j][0] * v[h][j][0] + v[h][j][1] * v[h][j][1]) + (v[h][j][2] * v[h][j][2] + v[h][j][3] * v[h][j][3]);
#pragma unroll
            for (int h = 0; h < 2; ++h) {
                const float rstd = 1.0f / sqrtf(wave_sum(s[h]) * (1.0f / DM) + RMS_EPS);
                const size_t rowg = row0 + r + h * NWAVES; const bool gat = !samp && (rowg & (SEQ - 1)) >= SEQ - 32;
                GAS u32x4* og = (GAS u32x4*)(F.HG + ((rowg >> 12) * 32 + (rowg & 31)) * DM) + lane;
                GAS u32x4* o = (GAS u32x4*)(F.H + (row0 + r + h * NWAVES) * DM) + lane; GAS u32x2* o8 = (GAS u32x2*)(F.H8 + (row0 + r + h * NWAVES) * PK_H8) + lane;
#pragma unroll
                for (int j = 0; j < 4; ++j) {
                    const f32x4 g0 = *(const LAS f32x4*)(gs + 8 * lane + 512 * j), g1 = *(const LAS f32x4*)(gs + 8 * lane + 512 * j + 4), s0 = *(const LAS f32x4*)(sh + 8 * lane + 512 * j), s1 = *(const LAS f32x4*)(sh + 8 * lane + 512 * j + 4);
                    const f32x4 h0 = v[h][2 * j] * rstd * g0 + s0, h1 = v[h][2 * j + 1] * rstd * g1 + s1;
                    if (outp) { const u32x4 hb = pack8(h0, h1); o[64 * j] = hb; if (gat) og[64 * j] = hb; }
                    o8[64 * j] = pack8_fp8(h0, h1);
                }
            }
        }
    }
    __syncthreads();
}

constexpr int KS_OFF = 0, KS_STRIDE = 144, VT_OFF = 28672, VT_STRIDE = 392;
__device__ __forceinline__ void attn_unit(Frame& F, int unit) {
    const int tid = F.tid, lane = F.lane, wave = F.wave;
    const bool samp = unit >= NB_P * 64 * 4;
    int b, j, kvh;
    if (!samp) { kvh = unit & 3; j = (unit >> 2) & 63; b = unit >> 8; } else { const int u2 = unit - NB_P * 64 * 4; kvh = u2 & 3; b = u2 >> 2; j = 0; }
    const int j0 = j > 2 ? j - 2 : 0, nk = j - j0 + 1, ntile = samp ? 5 : 2 * nk;
    LAS unsigned char* lds = F.lds;
#pragma unroll
    for (int i = 0; i < 3; ++i) {
        const int idx = tid + 512 * i; const int key = idx >> 3, ch = idx & 7;
        if (idx < (samp ? 1280 : nk * 512)) {
            u32x4 kv, vv;
            if (samp && key < WIN) {
                const size_t co = (((size_t)b * WIN + key) * 4 + kvh) * 64 + ch * 8;
                kv = pack8(*(const GAS f32x4*)(F.cache_k + co), *(const GAS f32x4*)(F.cache_k + co + 4));
                vv = pack8(*(const GAS f32x4*)(F.cache_v + co), *(const GAS f32x4*)(F.cache_v + co + 4));
            } else {
                const size_t row = samp ? (size_t)MP + b * SEQ_S + (key - WIN) : (size_t)b * SEQ + j0 * 64 + key;
                kv = *(const GAS u32x4*)(F.Kb + row * NKV + kvh * 64 + ch * 8); vv = *(const GAS u32x4*)(F.Vb + row * NKV + kvh * 64 + ch * 8);
            }
            *(LAS u32x4*)(lds + KS_OFF + key * KS_STRIDE + ch * 16) = kv;
            LAS unsigned short* vt = (LAS unsigned short*)(lds + VT_OFF + (ch * 8) * VT_STRIDE) + key;
            vt[0 * (VT_STRIDE / 2)] = (unsigned short)(vv.x & 0xffffu); vt[1 * (VT_STRIDE / 2)] = (unsigned short)(vv.x >> 16);
            vt[2 * (VT_STRIDE / 2)] = (unsigned short)(vv.y & 0xffffu); vt[3 * (VT_STRIDE / 2)] = (unsigned short)(vv.y >> 16);
            vt[4 * (VT_STRIDE / 2)] = (unsigned short)(vv.z & 0xffffu); vt[5 * (VT_STRIDE / 2)] = (unsigned short)(vv.z >> 16);
            vt[6 * (VT_STRIDE / 2)] = (unsigned short)(vv.w & 0xffffu); vt[7 * (VT_STRIDE / 2)] = (unsigned short)(vv.w >> 16);
        }
    }
    __syncthreads();
    if (!samp || wave < 4) {
        const int g = samp ? wave : (wave >> 1), tok0 = samp ? 0 : 32 * (wave & 1);
        const int head = kvh * 4 + g, q = lane & 31, hi = lane >> 5;
        const size_t qrow = (samp ? (size_t)MP + b * SEQ_S : (size_t)b * SEQ + j * 64) + tok0 + q;
        bf16x8 qf[4];
#pragma unroll
        for (int ds = 0; ds < 4; ++ds) qf[ds] = *(const GAS bf16x8*)(F.Qb + qrow * NQ + head * 64 + 16 * ds + 8 * hi);
        const float sinkl = *(const GAS float*)(F.sinks + head) * LOG2E;
        f32x16 st[6];
#pragma unroll
        for (int t = 0; t < 6; ++t) {
#pragma unroll
            for (int r = 0; r < 16; ++r) st[t][r] = 0.f;
            if (t < ntile) {
#pragma unroll
                for (int ds = 0; ds < 4; ++ds) { const bf16x8 kf = *(const LAS bf16x8*)(lds + KS_OFF + (32 * t + q) * KS_STRIDE + (16 * ds + 8 * hi) * 2);
                    st[t] = __builtin_amdgcn_mfma_f32_32x32x16_bf16(kf, qf[ds], st[t], 0, 0, 0); }
            }
        }
        float mx = sinkl;
#pragma unroll
        for (int t = 0; t < 6; ++t) if (t < ntile) {
#pragma unroll
            for (int r = 0; r < 16; ++r) mx = fmaxf(mx, st[t][r]); }
        mx = fmaxf(mx, __shfl_xor(mx, 32));
        float l = 0.f;
#pragma unroll
        for (int t = 0; t < 6; ++t) if (t < ntile) {
#pragma unroll
            for (int r = 0; r < 16; ++r) { const float p = __builtin_amdgcn_exp2f(st[t][r] - mx); st[t][r] = p; l += p; } }
        l += __shfl_xor(l, 32); l += __builtin_amdgcn_exp2f(sinkl - mx);
        const float rl = 1.0f / l;
        f32x16 ot[2];
#pragma unroll
        for (int d0 = 0; d0 < 2; ++d0)
#pragma unroll
            for (int r = 0; r < 16; ++r) ot[d0][r] = 0.f;
#pragma unroll
        for (int t = 0; t < 6; ++t) if (t < ntile) {
#pragma unroll
            for (int s = 0; s < 2; ++s) {
                u32x4 pw; pw.x = cvt_pk_bf16(st[t][8 * s], st[t][8 * s + 1]); pw.y = cvt_pk_bf16(st[t][8 * s + 2], st[t][8 * s + 3]); pw.z = cvt_pk_bf16(st[t][8 * s + 4], st[t][8 * s + 5]); pw.w = cvt_pk_bf16(st[t][8 * s + 6], st[t][8 * s + 7]);
                const bf16x8 pb = __builtin_bit_cast(bf16x8, pw);
#pragma unroll
                for (int d0 = 0; d0 < 2; ++d0) {
                    const LAS unsigned char* vp = lds + VT_OFF + (32 * d0 + q) * VT_STRIDE + (32 * t + 16 * s + 4 * hi) * 2;
                    const s16x4 lo = *(const LAS s16x4*)vp, h4 = *(const LAS s16x4*)(vp + 16);
                    const bf16x8 vf = (bf16x8){lo[0], lo[1], lo[2], lo[3], h4[0], h4[1], h4[2], h4[3]};
                    ot[d0] = __builtin_amdgcn_mfma_f32_32x32x16_bf16(vf, pb, ot[d0], 0, 0, 0);
                }
            }
        }
#pragma unroll
        for (int d0 = 0; d0 < 2; ++d0)
#pragma unroll
            for (int rq = 0; rq < 4; ++rq) {
                const size_t off = qrow * NQ + head * 64 + 32 * d0 + 8 * rq + 4 * hi;
                const u32x2 g2 = *(const GAS u32x2*)(F.SGA + off);
                const float rs = rl * A8_SCALE;
                int w = cvt2_fp8(ot[d0][4 * rq] * rs * bf_lo(g2.x), ot[d0][4 * rq + 1] * rs * bf_hi(g2.x), 0, false);
                w = cvt2_fp8(ot[d0][4 * rq + 2] * rs * bf_lo(g2.y), ot[d0][4 * rq + 3] * rs * bf_hi(g2.y), w, true);
                *(GAS unsigned*)((GAS unsigned char*)F.A1 + off + qrow * (PK_A12 - NQ)) = (unsigned)w;
            }
    }
    __syncthreads();
}

constexpr int AB_K0 = 0, AB_V0 = 27648, AB_IMG = 53760, AB_OST = 107520, OST_STRIDE = 144;
static_assert(AB_OST + 8 * 32 * OST_STRIDE <= LDSCTL_OFF, "attention LDS map");
__device__ __forceinline__ void attn_prompt_loop(Frame& F) {
    constexpr int NP = NB_P * 64 * 4;
    const int tid = F.tid, lane = F.lane, wave = F.wave;
    const int q = lane & 31, hi = lane >> 5, g = wave >> 1, tok0 = 32 * (wave & 1);
    const int rr8 = lane >> 3, c8 = lane & 7;
    LAS unsigned char* ost = F.lds + AB_OST + wave * (32 * OST_STRIDE);
    u32x4 kreg[3], vreg[3], qn[4];
#define AT_ISSUE(un_) do { const int b_ = (un_) >> 8, j_ = ((un_) >> 2) & 63, kvh_ = (un_) & 3, j0_ = j_ > 2 ? j_ - 2 : 0, nk_ = j_ - j0_ + 1; \
        _Pragma("unroll") for (int i_ = 0; i_ < 3; ++i_) { const int idx_ = tid + 512 * i_; if (idx_ < nk_ * 512) { const size_t ro_ = ((size_t)b_ * SEQ + j0_ * 64 + (idx_ >> 3)) * NKV + kvh_ * 64 + (idx_ & 7) * 8; \
            kreg[i_] = *(const GAS u32x4*)(F.Kb + ro_); vreg[i_] = *(const GAS u32x4*)(F.Vb + ro_); } } \
        const size_t qo_ = ((size_t)b_ * SEQ + j_ * 64 + tok0 + rr8) * NQ + (kvh_ * 4 + g) * 64 + 8 * c8; \
        _Pragma("unroll") for (int i_ = 0; i_ < 4; ++i_) qn[i_] = *(const GAS u32x4*)(F.Qb + qo_ + (size_t)(8 * i_) * NQ); } while (0)
    int un = F.vcu, par = 0;
    if (un < NP) AT_ISSUE(un);
    for (; un < NP; un += F.G, par ^= 1) {
        const int b = un >> 8, j = (un >> 2) & 63, kvh = un & 3, j0 = j > 2 ? j - 2 : 0, nk = j - j0 + 1, ntile = 2 * nk;
        LAS unsigned char* lds = F.lds + par * AB_IMG;
#pragma unroll
        for (int i = 0; i < 3; ++i) {
            const int idx = tid + 512 * i; const int key = idx >> 3, ch = idx & 7;
            if (idx < nk * 512) {
                const u32x4 kv = kreg[i], vv = vreg[i];
                *(LAS u32x4*)(lds + AB_K0 + key * KS_STRIDE + ch * 16) = kv;
                LAS unsigned short* vt = (LAS unsigned short*)(lds + AB_V0 + (ch * 8) * VT_STRIDE) + key;
                vt[0 * (VT_STRIDE / 2)] = (unsigned short)(vv.x & 0xffffu); vt[1 * (VT_STRIDE / 2)] = (unsigned short)(vv.x >> 16);
                vt[2 * (VT_STRIDE / 2)] = (unsigned short)(vv.y & 0xffffu); vt[3 * (VT_STRIDE / 2)] = (unsigned short)(vv.y >> 16);
                vt[4 * (VT_STRIDE / 2)] = (unsigned short)(vv.z & 0xffffu); vt[5 * (VT_STRIDE / 2)] = (unsigned short)(vv.z >> 16);
                vt[6 * (VT_STRIDE / 2)] = (unsigned short)(vv.w & 0xffffu); vt[7 * (VT_STRIDE / 2)] = (unsigned short)(vv.w >> 16);
            }
        }
#pragma unroll
        for (int i = 0; i < 4; ++i) *(LAS u32x4*)(ost + (rr8 + 8 * i) * OST_STRIDE + c8 * 16) = qn[i];
        __syncthreads();
        bf16x8 qf[4];
#pragma unroll
        for (int ds = 0; ds < 4; ++ds) qf[ds] = *(const LAS bf16x8*)(ost + q * OST_STRIDE + (16 * ds + 8 * hi) * 2);
        if (un + F.G < NP) AT_ISSUE(un + F.G);
        const int head = kvh * 4 + g;
        const size_t orow = ((size_t)b * SEQ + j * 64 + tok0 + rr8) * NQ + head * 64 + 8 * c8;
        const size_t orow8 = ((size_t)b * SEQ + j * 64 + tok0 + rr8) * PK_A12 + head * 64 + 8 * c8;
        u32x4 sg[4];
#pragma unroll
        for (int i = 0; i < 4; ++i) sg[i] = *(const GAS u32x4*)(F.SGA + orow + (size_t)(8 * i) * NQ);
        const float sinkl = *(const GAS float*)(F.sinks + head) * LOG2E;
        f32x16 st[6], zacc;
#pragma unroll
        for (int r = 0; r < 16; ++r) zacc[r] = 0.f;
#pragma unroll
        for (int t = 0; t < 6; ++t) {
            st[t] = zacc;
            if (t < ntile) {
#pragma unroll
                for (int ds = 0; ds < 4; ++ds) { const bf16x8 kf = *(const LAS bf16x8*)(lds + AB_K0 + (32 * t + q) * KS_STRIDE + (16 * ds + 8 * hi) * 2);
                    st[t] = __builtin_amdgcn_mfma_f32_32x32x16_bf16(kf, qf[ds], ds == 0 ? zacc : st[t], 0, 0, 0); }
            }
        }
        float mx = sinkl;
#pragma unroll
        for (int t = 0; t < 6; ++t) if (t < ntile) {
            float m0 = fmaxf(fmaxf(st[t][0], st[t][1]), st[t][2]), m1 = fmaxf(fmaxf(st[t][3], st[t][4]), st[t][5]), m2 = fmaxf(fmaxf(st[t][6], st[t][7]), st[t][8]), m3 = fmaxf(fmaxf(st[t][9], st[t][10]), st[t][11]);
            m0 = fmaxf(fmaxf(m0, st[t][12]), st[t][13]); m1 = fmaxf(fmaxf(m1, st[t][14]), st[t][15]); m2 = fmaxf(fmaxf(m2, m3), mx); mx = fmaxf(fmaxf(m0, m1), m2); }
        mx = fmaxf(mx, __shfl_xor(mx, 32));
        float l = 0.f;
#pragma unroll
        for (int t = 0; t < 6; ++t) if (t < ntile) {
#pragma unroll
            for (int r = 0; r < 16; ++r) { const float p = __builtin_amdgcn_exp2f(st[t][r] - mx); st[t][r] = p; l += p; } }
        l += __shfl_xor(l, 32); l += __builtin_amdgcn_exp2f(sinkl - mx);
        const float rl = 1.0f / l;
        f32x16 ot[2]; ot[0] = zacc; ot[1] = zacc;
#pragma unroll
        for (int t = 0; t < 6; ++t) if (t < ntile) {
#pragma unroll
            for (int s = 0; s < 2; ++s) {
                u32x4 pw; pw.x = cvt_pk_bf16(st[t][8 * s], st[t][8 * s + 1]); pw.y = cvt_pk_bf16(st[t][8 * s + 2], st[t][8 * s + 3]); pw.z = cvt_pk_bf16(st[t][8 * s + 4], st[t][8 * s + 5]); pw.w = cvt_pk_bf16(st[t][8 * s + 6], st[t][8 * s + 7]);
                const bf16x8 pb = __builtin_bit_cast(bf16x8, pw);
#pragma unroll
                for (int d0 = 0; d0 < 2; ++d0) {
                    const LAS unsigned char* vp = lds + AB_V0 + (32 * d0 + q) * VT_STRIDE + (32 * t + 16 * s + 4 * hi) * 2;
                    const s16x4 lo = *(const LAS s16x4*)vp, h4 = *(const LAS s16x4*)(vp + 16);
                    const bf16x8 vf = (bf16x8){lo[0], lo[1], lo[2], lo[3], h4[0], h4[1], h4[2], h4[3]};
                    ot[d0] = __builtin_amdgcn_mfma_f32_32x32x16_bf16(vf, pb, ot[d0], 0, 0, 0);
                }
            }
        }
#pragma unroll
        for (int d0 = 0; d0 < 2; ++d0)
#pragma unroll
            for (int rq = 0; rq < 4; ++rq) {
                u32x2 w; w.x = cvt_pk_bf16(ot[d0][4 * rq] * rl, ot[d0][4 * rq + 1] * rl); w.y = cvt_pk_bf16(ot[d0][4 * rq + 2] * rl, ot[d0][4 * rq + 3] * rl);
                *(LAS u32x2*)(ost + q * OST_STRIDE + (32 * d0 + 8 * rq + 4 * hi) * 2) = w;
            }
        LDS_WAIT();
#pragma unroll
        for (int i = 0; i < 4; ++i) {
            const u32x4 o4 = *(const LAS u32x4*)(ost + (rr8 + 8 * i) * OST_STRIDE + c8 * 16), g4 = sg[i];
            const f32x4 p0 = (f32x4){bf_lo(o4.x) * bf_lo(g4.x), bf_hi(o4.x) * bf_hi(g4.x), bf_lo(o4.y) * bf_lo(g4.y), bf_hi(o4.y) * bf_hi(g4.y)} * A8_SCALE;
            const f32x4 p1 = (f32x4){bf_lo(o4.z) * bf_lo(g4.z), bf_hi(o4.z) * bf_hi(g4.z), bf_lo(o4.w) * bf_lo(g4.w), bf_hi(o4.w) * bf_hi(g4.w)} * A8_SCALE;
            *(GAS u32x2*)((GAS unsigned char*)F.A1 + orow8 + (size_t)(8 * i) * PK_A12) = pack8_fp8(p0, p1);
        }
        LDS_WAIT();
    }
#undef AT_ISSUE
    __syncthreads();
}

template <int I> __device__ __forceinline__ void conv_row(f32x2 (&y)[32], const f32x2 (&w)[CW], const unsigned (&pk)[32 + HIST]) {
    if constexpr (I < 32 + HIST) {
        const f32x2 u = (f32x2){bf_lo(pk[I]), bf_hi(pk[I])};
        constexpr int lo = I - (CW - 1) > 0 ? I - (CW - 1) : 0, hi = I < 31 ? I : 31;
#pragma unroll
        for (int o = lo; o <= hi; ++o) y[o] = __builtin_elementwise_fma(w[I - o], u, y[o]);
        conv_row<I + 1>(y, w, pk);
    }
}
__device__ __forceinline__ void conv_phase(Frame& F, int first, int stride) {
    const int tid = F.tid, lane = F.lane, wave = F.wave;
    LAS float* red = (LAS float*)(F.lds + 65536);
    LAS float* stats = red + 8 * 64;
    f32x2 wv[CW];
#pragma unroll
    for (int w = 0; w < CW; ++w) wv[w] = *(const GAS f32x2*)(F.w_dw + w * CD + 2 * tid);
    const f32x2 bdw = *(const GAS f32x2*)(F.b_dw + 2 * tid), lg = *(const GAS f32x2*)(F.ln_g + 2 * tid), lb = *(const GAS f32x2*)(F.ln_b + 2 * tid);
    constexpr int NU_P = MP / 32, NU = NU_P + NB_S, NR = 32 + HIST;
    for (int unit = first; unit < NU; unit += stride) {
        const bool samp = unit >= NU_P;
        const int b = samp ? unit - NU_P : unit >> 7, t0 = samp ? 0 : (unit & 127) * 32;
        const size_t rowbase = samp ? (size_t)MP + b * SEQ_S : (size_t)b * SEQ;
        unsigned pk[NR];
        if (t0 != 0) {
            const GAS bf16_t* rp = (const GAS bf16_t*)F.U + (rowbase + t0 - HIST) * CD + 2 * tid;
#pragma unroll
            for (int i = 0; i < NR; ++i) { pk[i] = *(const GAS unsigned*)rp; rp += CD; asm volatile("" : "+v"(rp)); }
        } else {
            const GAS bf16_t* hp = (const GAS bf16_t*)(samp ? F.UH + (size_t)b * HIST * CD : F.ZROW) + 2 * tid; const int hstride = samp ? CD : 0;
#pragma unroll
            for (int i = 0; i < HIST; ++i) { pk[i] = *(const GAS unsigned*)hp; hp += hstride; asm volatile("" : "+v"(hp)); }
            const GAS bf16_t* rp = (const GAS bf16_t*)F.U + rowbase * CD + 2 * tid;
#pragma unroll
            for (int i = HIST; i < NR; ++i) { pk[i] = *(const GAS unsigned*)rp; rp += CD; asm volatile("" : "+v"(rp)); }
        }
        f32x2 yv[32];
#pragma unroll
        for (int o = 0; o < 32; ++o) yv[o] = bdw;
        conv_row<0>(yv, wv, pk);
        unsigned gb[32];
        const GAS bf16_t* gp = (const GAS bf16_t*)F.SGB + (rowbase + t0) * CD + 2 * tid;
#pragma unroll
        for (int o = 0; o < 32; ++o) { gb[o] = *(const GAS unsigned*)gp; gp += CD; asm volatile("" : "+v"(gp)); }
        float a5[32], a4[16], a3[8], a2[4], a1[2], a0;
        { const bool up = (lane & 32) != 0;
#pragma unroll
          for (int j = 0; j < 32; ++j) { const float s1 = yv[j][0] + yv[j][1], s2 = yv[j][0] * yv[j][0] + yv[j][1] * yv[j][1]; const float keep = up ? s2 : s1, send = up ? s1 : s2; a5[j] = keep + __shfl_xor(send, 32); } }
        { const bool up = (lane & 16) != 0;
#pragma unroll
          for (int j = 0; j < 16; ++j) { const float keep = up ? a5[16 + j] : a5[j], send = up ? a5[j] : a5[16 + j]; a4[j] = keep + __shfl_xor(send, 16); } }
        { const bool up = (lane & 8) != 0;
#pragma unroll
          for (int j = 0; j < 8; ++j) { const float keep = up ? a4[8 + j] : a4[j], send = up ? a4[j] : a4[8 + j]; a3[j] = keep + __shfl_xor(send, 8); } }
        { const bool up = (lane & 4) != 0;
#pragma unroll
          for (int j = 0; j < 4; ++j) { const float keep = up ? a3[4 + j] : a3[j], send = up ? a3[j] : a3[4 + j]; a2[j] = keep + __shfl_xor(send, 4); } }
        { const bool up = (lane & 2) != 0;
#pragma unroll
          for (int j = 0; j < 2; ++j) { const float keep = up ? a2[2 + j] : a2[j], send = up ? a2[j] : a2[2 + j]; a1[j] = keep + __shfl_xor(send, 2); } }
        { const bool up = (lane & 1) != 0; const float keep = up ? a1[1] : a1[0], send = up ? a1[0] : a1[1]; a0 = keep + __shfl_xor(send, 1); }
        red[wave * 64 + lane] = a0;
        __syncthreads();
        if (tid < 32) {
            float S1 = 0.f, S2 = 0.f;
#pragma unroll
            for (int wv = 0; wv < NWAVES; ++wv) { S1 += red[wv * 64 + tid]; S2 += red[wv * 64 + 32 + tid]; }
            const float mean = S1 * (1.0f / CD), var = fmaxf(S2 * (1.0f / CD) - mean * mean, 0.f);
            *(LAS f32x2*)(stats + 2 * tid) = (f32x2){mean, 1.0f / sqrtf(var + LN_EPS)};
        }
        __syncthreads();
        GAS unsigned char* op = (GAS unsigned char*)F.A2 + (rowbase + t0) * PK_A12 + 2 * tid;
#pragma unroll
        for (int o = 0; o < 32; ++o) {
            const f32x2 st = *(const LAS f32x2*)(stats + 2 * o);
            const float n0 = (yv[o][0] - st[0]) * st[1] * lg[0] + lb[0], n1 = (yv[o][1] - st[0]) * st[1] * lg[1] + lb[1];
            *(GAS unsigned short*)op = (unsigned short)cvt2_fp8(n0 * fast_sigmoid(n0) * bf_lo(gb[o]) * A8_SCALE, n1 * fast_sigmoid(n1) * bf_hi(gb[o]) * A8_SCALE, 0, false); op += PK_A12; asm volatile("" : "+v"(op));
        }
    }
    __syncthreads();
}

__device__ __forceinline__ void side_outputs(Frame& F) {
    const int gt = F.vcu * (NWAVES * 64) + F.tid, NGT = F.G * NWAVES * 64;
    constexpr int G_KP = NB_P * WIN * NKV / 8, G_KS = NB_S * SEQ_S * NKV / 8, G_CP = NB_P * HIST * CD / 8, G_CS = NB_S * HIST * CD / 8;
    for (int e = gt; e < 2 * G_KP + 2 * G_KS + G_CP + G_CS; e += NGT) {
        int r = e; const bf16_t* src; float* dst;
        if (r < 2 * G_KP) { const int which = r / G_KP; r %= G_KP; const int b = r / (WIN * NKV / 8), rem = r % (WIN * NKV / 8), i = rem / (NKV / 8), c8 = rem % (NKV / 8);
            src = (which ? F.Vb : F.Kb) + ((size_t)b * SEQ + SEQ - WIN + i) * NKV + c8 * 8; dst = F.out + (which ? OV_P : OK_P) + ((size_t)b * WIN + i) * NKV + c8 * 8; }
        else if (r < 2 * G_KP + 2 * G_KS) { r -= 2 * G_KP; const int which = r / G_KS; r %= G_KS; const int b = r / (SEQ_S * NKV / 8), rem = r % (SEQ_S * NKV / 8), t = rem / (NKV / 8), c8 = rem % (NKV / 8);
            src = (which ? F.Vb : F.Kb) + ((size_t)MP + b * SEQ_S + t) * NKV + c8 * 8; dst = F.out + (which ? OV_S : OK_S) + ((size_t)b * WIN + (WIN - SEQ_S) + t) * NKV + c8 * 8; }
        else if (r < 2 * G_KP + 2 * G_KS + G_CP) { r -= 2 * G_KP + 2 * G_KS; const int b = r / (HIST * CD / 8), rem = r % (HIST * CD / 8), i = rem / (CD / 8), c8 = rem % (CD / 8);
            src = F.UX + ((size_t)b * 32 + (32 - HIST) + i) * CD + c8 * 8; dst = F.out + OC_P + ((size_t)b * HIST + i) * CD + c8 * 8; }
        else { r -= 2 * G_KP + 2 * G_KS + G_CP; const int b = r / (HIST * CD / 8), rem = r % (HIST * CD / 8), i = rem / (CD / 8), c8 = rem % (CD / 8);
            src = F.U + ((size_t)MP + b * SEQ_S + (SEQ_S - HIST) + i) * CD + c8 * 8; dst = F.out + OC_S + ((size_t)b * HIST + i) * CD + c8 * 8; }
        const u32x4 v = *(const GAS u32x4*)src;
        *(GAS f32x4*)dst = (f32x4){bf_lo(v.x), bf_hi(v.x), bf_lo(v.y), bf_hi(v.y)}; *(GAS f32x4*)(dst + 4) = (f32x4){bf_lo(v.z), bf_hi(v.z), bf_lo(v.w), bf_hi(v.w)};
    }
}

__device__ __forceinline__ void p6_final(Frame& F, const bf16_t* ybr) {
    const int gw = F.vcu * NWAVES + F.wave, NGW = F.G * NWAVES, lane = F.lane;
    f32x4 fg[4][2];
#pragma unroll
    for (int j = 0; j < 4; ++j) { fg[j][0] = *(const GAS f32x4*)(F.final_g + 8 * lane + 512 * j); fg[j][1] = *(const GAS f32x4*)(F.final_g + 8 * lane + 512 * j + 4); }
    u32x4 b[2][4]; f32x4 x[2][8];
#define P6_ISSUE(r_, buf_) do { const int rc_ = (r_) < M ? (r_) : M - 1; const GAS u32x4* br_ = (const GAS u32x4*)(ybr + (size_t)rc_ * DM) + lane; \
        const GAS f32x4* xr_ = (const GAS f32x4*)(rc_ < MP ? F.xp + (size_t)rc_ * DM : F.xs + (size_t)(rc_ - MP) * DM) + 2 * lane; \
        _Pragma("unroll") for (int j_ = 0; j_ < 4; ++j_) { b[buf_][j_] = br_[64 * j_]; x[buf_][2 * j_] = xr_[128 * j_]; x[buf_][2 * j_ + 1] = xr_[128 * j_ + 1]; } } while (0)
#define P6_ROW(r_, buf_) do { float ss_ = 0.f; \
        _Pragma("unroll") for (int j_ = 0; j_ < 4; ++j_) { const u32x4 w_ = b[buf_][j_]; \
            x[buf_][2 * j_] += (f32x4){bf_lo(w_.x), bf_hi(w_.x), bf_lo(w_.y), bf_hi(w_.y)}; x[buf_][2 * j_ + 1] += (f32x4){bf_lo(w_.z), bf_hi(w_.z), bf_lo(w_.w), bf_hi(w_.w)}; \
            const f32x4 a_ = x[buf_][2 * j_], c_ = x[buf_][2 * j_ + 1]; \
            ss_ += ((a_[0] * a_[0] + a_[1] * a_[1]) + (a_[2] * a_[2] + a_[3] * a_[3])) + ((c_[0] * c_[0] + c_[1] * c_[1]) + (c_[2] * c_[2] + c_[3] * c_[3])); } \
        const float rstd_ = 1.0f / sqrtf(wave_sum(ss_) * (1.0f / DM) + RMS_EPS); \
        GAS f32x4* o_ = (GAS f32x4*)(F.out + (size_t)(r_) * DM) + 2 * lane; \
        _Pragma("unroll") for (int j_ = 0; j_ < 4; ++j_) { o_[128 * j_] = x[buf_][2 * j_] * rstd_ * fg[j_][0]; o_[128 * j_ + 1] = x[buf_][2 * j_ + 1] * rstd_ * fg[j_][1]; } } while (0)
    int row = gw;
    if (row < M) P6_ISSUE(row, 0);
    for (; row < M; row += 2 * NGW) {
        P6_ISSUE(row + NGW, 1);
        P6_ROW(row, 0);
        if (row + NGW < M) { P6_ISSUE(row + 2 * NGW, 0); P6_ROW(row + NGW, 1); }
    }
#undef P6_ISSUE
#undef P6_ROW
}

constexpr int N_PHASES = 7;
constexpr int WGM1 = 2, WGM2 = 2, WGM3 = 2;
constexpr int REP[7] = {1, 1, 1, 1, 1, 1, 1};
#ifndef MK_N_LAUNCHES
#define MK_N_LAUNCHES 1
#endif
struct Args { const float* in[20]; float* out; unsigned char* ws; int ph_lo, ph_hi; };
__global__ void __launch_bounds__(NWAVES * 64, 2) skel_fwd(Args args) {
    extern __shared__ __attribute__((aligned(16))) unsigned char lds_raw[];
    Frame F;
    F.lds = (LAS unsigned char*)lds_raw;
    F.tid = threadIdx.x; F.lane = F.tid & 63; F.wave = __builtin_amdgcn_readfirstlane(F.tid >> 6);
    F.G = gridDim.x; { const int bx = blockIdx.x; F.vcu = (F.G % 8 == 0) ? (bx % 8) * (F.G / 8) + bx / 8 : bx; }
    unsigned char* ws = args.ws;
    F.xp = args.in[0]; F.xs = args.in[1]; F.cp = args.in[2]; F.cs = args.in[3]; F.cache_k = args.in[4]; F.cache_v = args.in[5]; F.state_conv = args.in[6];
    F.norm_g = args.in[7]; F.w_ada = args.in[8]; F.b_ada = args.in[9]; F.w_in = args.in[10]; F.sinks = args.in[11]; F.w_dw = args.in[12]; F.b_dw = args.in[13];
    F.ln_g = args.in[14]; F.ln_b = args.in[15]; F.w_pa = args.in[16]; F.w_pb = args.in[17]; F.w_out = args.in[18]; F.final_g = args.in[19];
    F.out = args.out;
    F.gate = (float*)(ws + WS_GATE); F.ropec = (float*)(ws + WS_ROPE_C); F.ropes = (float*)(ws + WS_ROPE_S); F.rss = (float*)(ws + WS_RSS); F.part = (float*)(ws + WS_PART);
    F.Win_t = (bf16_t*)(ws + WS_WIN); F.Wa_t = (bf16_t*)(ws + WS_WA); F.Wb_t = (bf16_t*)(ws + WS_WB); F.Wo_t = (bf16_t*)(ws + WS_WO);
    F.W8 = ws + WS_W8; F.H8 = ws + WS_H8;
    F.H = (bf16_t*)(ws + WS_H); F.Qb = (bf16_t*)(ws + WS_Q); F.Kb = (bf16_t*)(ws + WS_K); F.Vb = (bf16_t*)(ws + WS_V);
    F.SGA = (bf16_t*)(ws + WS_SGA); F.U = (bf16_t*)(ws + WS_U); F.SGB = (bf16_t*)(ws + WS_SGB); F.SMG = (bf16_t*)(ws + WS_SMG); F.A1 = (bf16_t*)(ws + WS_A1); F.A2 = (bf16_t*)(ws + WS_A2); F.UH = (bf16_t*)(ws + WS_UH); F.UX = (bf16_t*)(ws + WS_UX); F.HG = (bf16_t*)(ws + WS_HG); F.ZROW = (bf16_t*)(ws + WS_ZROW);
    for (int u = F.tid; u < (LDS_BYTES - LDSCTL_OFF) / 4; u += NWAVES * 64) ((LAS unsigned*)(F.lds + LDSCTL_OFF))[u] = 0u;
    __syncthreads();
    unsigned* ctl = (unsigned*)(ws + WS_CTL);
    XcdBarrier bar; bar.bar = ctl + CW_BAR; bar.x = 0; bar.st = nullptr;
    const int lo = args.ph_lo, hi = args.ph_hi;
    if (hi - lo > 1) bar = xcd_barrier_post(ctl + CW_BAR, (volatile LAS unsigned*)(F.lds + MISC_OFF) + 8);
#define IN(k) (lo <= (k) && (k) < hi)
#define SEAM(k) do { if (IN(k) && IN((k) + 1)) xcd_barrier(bar); } while (0)

    if (IN(0)) { for (int rep = 0; rep < REP[0]; ++rep) p0_prologue(F); SEAM(0); }
    if (IN(1)) { for (int rep = 0; rep < REP[1]; ++rep) { p1_hrows(F); p1_weights(F); } SEAM(1); }
    if (IN(2)) {
        constexpr int NU_B = 64;
        const int nb = F.G >= 2 * NU_B ? NU_B : 0;
        { pg8::Gemm g{F.H, F.HG, F.Win_t, F.Win_t, DM}; pg8::Order S; S.init_inproj(3, F.G, (int)blockIdx.x, F.vcu, WGM1, 0);
          Epi1<false> E{F.Qb, F.Kb, F.Vb, F.SGA, F.U, F.SGB, F.SMG, F.ropec, F.ropes, F.UX};
          for (int rep = 0; rep < REP[2]; ++rep) pg8::gemm_phase<Epi1<false>, true, true, false>(F.lds + RING_OFF, g, S, E); }
        { pg8::Gemm g{F.H8, F.H8, F.W8, F.W8, DM, PK_H8, PK_W8}; pg8::Order S; S.init_inproj(4, F.G, (int)blockIdx.x, F.vcu, WGM1, nb);
          Epi1<true> E{F.Qb, F.Kb, F.Vb, F.SGA, F.U, F.SGB, F.SMG, F.ropec, F.ropes, F.UX};
          for (int rep = 0; rep < REP[2]; ++rep) pg8::gemm_phase<Epi1<true>, true, true, true>(F.lds + RING_OFF, g, S, E); }
        p2_fill(F, (int)blockIdx.x, F.G);
        SEAM(2);
    }
    if (IN(3)) {
        constexpr int NATT = NB_P * 64 * 4 + NB_S * 4;
        for (int rep = 0; rep < REP[3]; ++rep) {
        attn_prompt_loop(F);
        for (int it = F.vcu; it < NATT; it += F.G) if (it >= NB_P * 64 * 4) attn_unit(F, it);
        conv_phase(F, F.G - 1 - F.vcu, F.G);
        side_outputs(F);
        }
        SEAM(3);
    }
    if (IN(4)) {
        bf16_t* MG = F.H;
        pg8::Gemm g{F.A1, F.A2, F.Wa_t, F.Wb_t, NQ, PK_A12, PK_WAB}; pg8::Order S; S.init(M, DM, F.G, (int)blockIdx.x, 1, F.vcu, 1, WGM2);
        Epi2 E{MG, F.SMG};
        for (int rep = 0; rep < REP[4]; ++rep) pg8::gemm_phase<Epi2, true, true, true>(F.lds + RING_OFF, g, S, E);
        SEAM(4);
    }
    if (IN(5)) {
        pg8::Gemm g{F.H, F.H, F.Wo_t, F.Wo_t, DM, PK_MG, PK_WO}; pg8::Order S; S.init(M, DM, F.G, (int)blockIdx.x, 0, F.vcu, 1, WGM3);
        Epi3 E{F.gate, (bf16_t*)(ws + WS_YPRE)};
        for (int rep = 0; rep < REP[5]; ++rep) pg8::gemm_phase<Epi3, true, true, true>(F.lds + RING_OFF, g, S, E);
        SEAM(5);
    }
    if (IN(6)) p6_final(F, (const bf16_t*)(ws + WS_YPRE));
#undef IN
#undef SEAM
}

extern "C" void kernel_launch(void* const* d_in, const int* in_sizes, int n_in, void* d_out, int out_size, void* d_ws, size_t ws_size, hipStream_t stream) {
    static int grid = 0;
    if (grid == 0) {
        if (n_in != 20 || (size_t)out_size != OUT_TOTAL || ws_size < WS_END) { fprintf(stderr, "kernel_launch: unexpected shapes (n_in %d, out %d, ws %zu); nothing launched\n", n_in, out_size, ws_size); grid = -1; return; }
        int dev = 0, cus = 0;
        if (hipGetDevice(&dev) != hipSuccess || hipDeviceGetAttribute(&cus, hipDeviceAttributeMultiprocessorCount, dev) != hipSuccess) { grid = -1; return; }
        if (hipFuncSetAttribute((const void*)skel_fwd, hipFuncAttributeMaxDynamicSharedMemorySize, LDS_BYTES) != hipSuccess) { fprintf(stderr, "kernel_launch: hipFuncSetAttribute failed\n"); grid = -1; return; }
        int per_cu = 0;
        if (hipOccupancyMaxActiveBlocksPerMultiprocessor(&per_cu, (const void*)skel_fwd, NWAVES * 64, LDS_BYTES) != hipSuccess || per_cu < 1) fprintf(stderr, "kernel_launch: occupancy query reports %d\n", per_cu);
        (void)hipGetLastError();
        grid = cus;
    }
    if (grid < 0) return;
    if (hipMemsetAsync((char*)d_ws + WS_CTL, 0, CTL_ZERO_BYTES, stream) != hipSuccess) return;
    Args a{};
    for (int i = 0; i < 20; ++i) a.in[i] = (const float*)d_in[i];
    a.out = (float*)d_out; a.ws = (unsigned char*)d_ws;
#if MK_N_LAUNCHES == 1
    a.ph_lo = 0; a.ph_hi = N_PHASES;
    hipLaunchKernelGGL(skel_fwd, dim3(grid), dim3(NWAVES * 64), LDS_BYTES, stream, a);
#else
    for (int p = 0; p < N_PHASES; ++p) { a.ph_lo = p; a.ph_hi = p + 1; hipLaunchKernelGGL(skel_fwd, dim3(grid), dim3(NWAVES * 64), LDS_BYTES, stream, a); }
#endif
}
```

```cpp
#include <hip/hip_runtime.h>
#include <cstdio>
#include <cstdint>

#define GAS __attribute__((address_space(1)))
#define LAS __attribute__((address_space(3)))
typedef unsigned short bf16_t;
typedef short bf16x8 __attribute__((ext_vector_type(8)));
typedef short s16x4 __attribute__((ext_vector_type(4)));
typedef float f32x2 __attribute__((ext_vector_type(2)));
typedef float f32x4 __attribute__((ext_vector_type(4)));
typedef float f32x16 __attribute__((ext_vector_type(16)));
typedef unsigned u32x2 __attribute__((ext_vector_type(2)));
typedef unsigned u32x4 __attribute__((ext_vector_type(4)));
typedef int i32x4 __attribute__((ext_vector_type(4)));
typedef int i32x8 __attribute__((ext_vector_type(8)));

constexpr int DM = 2048, NB_P = 8, SEQ = 4096, NB_S = 32, SEQ_S = 32, PAST = 1024;
constexpr int MP = NB_P * SEQ, MS = NB_S * SEQ_S, M = MP + MS;
constexpr int NQ = 1024, NKV = 256, CD = 1024, IN_DIM = 9728, NMG = 4096;
constexpr int NMOD = 40, MOD_N = 3 * DM, KS_ADA = 8;
constexpr int CW = 31, HIST = 30, WIN = 128;
constexpr float RMS_EPS = 1e-6f, LN_EPS = 1e-5f;
constexpr float LOG2E = 1.4426950408889634f;
constexpr float W8_SCALE = 32.0f, MG8_SCALE = 8.0f, A8_SCALE = 16.0f;
constexpr int PK_H8 = 2048, PK_W8 = 2048, PK_A12 = 1024, PK_WAB = 1024, PK_WO = 2048, PK_MG = 2048 + 128;
constexpr float QSCALE = 0.125f * LOG2E;

constexpr size_t OY = 0;
constexpr size_t OK_P = (size_t)M * DM;
constexpr size_t OV_P = OK_P + (size_t)NB_P * WIN * NKV;
constexpr size_t OC_P = OV_P + (size_t)NB_P * WIN * NKV;
constexpr size_t OK_S = OC_P + (size_t)NB_P * HIST * CD;
constexpr size_t OV_S = OK_S + (size_t)NB_S * WIN * NKV;
constexpr size_t OC_S = OV_S + (size_t)NB_S * WIN * NKV;
constexpr size_t OUT_TOTAL = OC_S + (size_t)NB_S * HIST * CD;

constexpr size_t MiB = 1u << 20;
constexpr size_t WS_CTL = 0, CTL_ZERO_BYTES = 32 * 1024;
constexpr size_t WS_GATE = 1 * MiB;
constexpr size_t WS_ROPE_C = 1 * MiB + 512 * 1024, WS_ROPE_S = 2 * MiB;
constexpr size_t WS_RSS = 8 * MiB;
constexpr size_t WS_PART = 8 * MiB;
constexpr size_t WS_WIN = 24 * MiB;
constexpr size_t WS_WA = 62 * MiB, WS_WB = 66 * MiB, WS_WO = 70 * MiB;
constexpr size_t WS_H = 80 * MiB;
constexpr size_t WS_Q = 212 * MiB;
constexpr size_t WS_K = 278 * MiB, WS_V = 295 * MiB;
constexpr size_t WS_SGA = 312 * MiB, WS_U = 378 * MiB, WS_SGB = 444 * MiB;
constexpr size_t WS_YPRE = WS_SGA;
static_assert(WS_U == WS_SGA + (size_t)66 * MiB && WS_SGB == WS_U + (size_t)66 * MiB, "YPRE overlay");
constexpr size_t WS_SMG = 510 * MiB;
constexpr size_t WS_A2 = 774 * MiB;
constexpr size_t WS_UH = 840 * MiB;
constexpr size_t WS_ZROW = 842 * MiB;
constexpr size_t WS_UX = 842 * MiB + 65536;
constexpr size_t WS_HG = 4 * MiB;
constexpr size_t WS_A1 = 843 * MiB;
constexpr size_t WS_W8 = 881 * MiB;
constexpr size_t WS_H8 = 902 * MiB;
constexpr size_t WS_END = 973 * MiB;
static_assert(WS_A1 + (size_t)M * PK_A12 <= WS_W8 && WS_W8 + (size_t)IN_DIM * PK_W8 <= WS_H8 && WS_H8 + (size_t)M * PK_H8 <= WS_END && WS_A2 + (size_t)M * PK_A12 <= WS_UH, "ws map 4");
static_assert(WS_WA + (size_t)DM * PK_WAB <= WS_WB && WS_WB + (size_t)DM * PK_WAB <= WS_WO && WS_WO + (size_t)DM * PK_WO <= WS_H, "ws map 5");
static_assert(WS_RSS + (size_t)M * 64 * 4 <= WS_WIN && WS_PART + (size_t)KS_ADA * NMOD * MOD_N * 4 <= WS_WIN && WS_WIN + (size_t)IN_DIM * DM * 2 <= WS_WA, "ws map 1");
static_assert(WS_H + (size_t)M * DM * 2 <= WS_Q && WS_Q + (size_t)M * NQ * 2 <= WS_K && WS_K + (size_t)M * NKV * 2 <= WS_V && WS_V + (size_t)M * NKV * 2 <= WS_SGA, "ws map 2");
static_assert(WS_SMG + (size_t)M * NMG * 2 <= WS_A2 && WS_A2 + (size_t)M * CD * 2 <= WS_UH, "ws map 3");
constexpr int CW_TMO = 0, CW_CODE = 1, CW_BAR = 4096;

constexpr int RING_OFF = 0, RING_BYTES = 131072;
constexpr int LDSCTL_OFF = 144384, MISC_OFF = LDSCTL_OFF + 320;
constexpr int LDS_BYTES = 147456;
constexpr int NWAVES = 8;

#define LDS_WAIT() asm volatile("s_waitcnt lgkmcnt(0)" ::: "memory")
#define VM_WAIT() asm volatile("s_waitcnt vmcnt(0)" ::: "memory")
__device__ __forceinline__ unsigned cvt_pk_bf16(float lo, float hi) { unsigned r; asm volatile("v_cvt_pk_bf16_f32 %0, %1, %2" : "=v"(r) : "v"(lo), "v"(hi)); return r; }
__device__ __forceinline__ unsigned pack4_u8(f32x4 v, unsigned lo) {
    unsigned q0 = (unsigned)(v[0] * 255.0f + 0.5f), q1 = (unsigned)(v[1] * 255.0f + 0.5f), q2 = (unsigned)(v[2] * 255.0f + 0.5f), q3 = (unsigned)(v[3] * 255.0f + 0.5f);
    q0 = q0 > lo ? q0 : lo; q1 = q1 > lo ? q1 : lo; q2 = q2 > lo ? q2 : lo; q3 = q3 > lo ? q3 : lo;
    return q0 | (q1 << 8) | (q2 << 16) | (q3 << 24);
}
__device__ __forceinline__ f32x4 unpack4_u8(unsigned w) { return (f32x4){(float)(w & 0xffu), (float)((w >> 8) & 0xffu), (float)((w >> 16) & 0xffu), (float)(w >> 24)}; }
__device__ __forceinline__ float bf_lo(unsigned u) { return __uint_as_float(u << 16); }
__device__ __forceinline__ float bf_hi(unsigned u) { return __uint_as_float(u & 0xffff0000u); }
__device__ __forceinline__ float fast_sigmoid(float x) { return __builtin_amdgcn_rcpf(1.0f + __builtin_amdgcn_exp2f(-LOG2E * x)); }
__device__ __forceinline__ u32x4 pack8(f32x4 a, f32x4 b) { u32x4 w; w.x = cvt_pk_bf16(a[0], a[1]); w.y = cvt_pk_bf16(a[2], a[3]); w.z = cvt_pk_bf16(b[0], b[1]); w.w = cvt_pk_bf16(b[2], b[3]); return w; }
__device__ __forceinline__ float sat8(float x) { return __builtin_amdgcn_fmed3f(x, -448.0f, 448.0f); }
__device__ __forceinline__ int cvt2_fp8(float a, float b, int old, bool hi) { return hi ? __builtin_amdgcn_cvt_pk_fp8_f32(sat8(a), sat8(b), old, true) : __builtin_amdgcn_cvt_pk_fp8_f32(sat8(a), sat8(b), old, false); }
__device__ __forceinline__ u32x2 pack8_fp8(f32x4 a, f32x4 b) { int w0 = cvt2_fp8(a[0], a[1], 0, false); w0 = cvt2_fp8(a[2], a[3], w0, true);
    int w1 = cvt2_fp8(b[0], b[1], 0, false); w1 = cvt2_fp8(b[2], b[3], w1, true); u32x2 r; r.x = (unsigned)w0; r.y = (unsigned)w1; return r; }
__device__ __forceinline__ float wave_sum(float v) {
#pragma unroll
    for (int o = 1; o < 64; o <<= 1) v += __shfl_xor(v, o);
    return v;
}

namespace pg8 {
constexpr int BM = 256, BK = 64, HALF = 128, HTB = HALF * BK * 2, STAGE_BYTES = 8 * HTB, NXCD = 8, WGM = 8;
__host__ __device__ __forceinline__ int lds_byte(int r, int c) { const int st = (r >> 4) * 2 + (c >> 5), rr = r & 15, cc = c & 31, ob = rr * 64 + cc * 2; return st * 1024 + (ob ^ (((ob >> 9) & 1) << 5)); }
__host__ __device__ __forceinline__ void stage_rc(int b, int& R, int& C) { const int st = b / 1024, sb = b % 1024, swz = sb ^ (((sb >> 9) & 1) << 5); R = (st >> 1) * 16 + swz / 64; C = (st & 1) * 32 + (swz % 64) / 2; }
__host__ __device__ __forceinline__ int perm32(int rho) { const int n = rho >> 4, i = rho & 15; return 8 * (i >> 2) + 4 * n + (i & 3); }

__host__ __device__ __forceinline__ int lds_byte8(int r, int cb) { const int st = (r >> 4) * 2 + (cb >> 6), ob = (r & 15) * 64 + (cb & 63); return st * 1024 + (ob ^ (((ob >> 9) & 1) << 4)); }
__host__ __device__ __forceinline__ void stage_rc8(int b, int& R, int& CB) { const int st = b / 1024, sb = b % 1024, swz = sb ^ (((sb >> 9) & 1) << 4); R = (st >> 1) * 16 + swz / 64; CB = (st & 1) * 64 + swz % 64; }
struct Unit { int pm, pn, sel, qm; };
struct Gemm { const void* A0; const void* A1; const void* B0; const void* B1; int K; int pitchA = 0, pitchB = 0; };

struct Order {
    int nM, nN, nwg, G, c, pair, vcu, qtail, wgm, pmode = 0, nM2 = 0, nN2 = 0, nM3 = 0, nN3 = 0, cut = 0, nb = 0;
    __device__ __forceinline__ void init(int M_, int N_, int G_, int c_, int pair_, int vcu_, int qtail_, int wgm_) { wgm = wgm_; nM = M_ / BM; nN = N_ / BM; nwg = nM * nN; G = G_; c = c_; pair = pair_; vcu = vcu_;
        qtail = (qtail_ && (nwg % G_) != 0 && (nwg % G_) * 4 <= G_) ? 1 : 0; }
    __device__ __forceinline__ void init_inproj(int mode, int G_, int c_, int vcu_, int wgm_, int nb_) { wgm = wgm_; G = G_; c = c_; pair = 0; vcu = vcu_; qtail = 0; pmode = mode;
        nM = 8; nN = mode == 3 ? 2 : 36; nM2 = 4; nN2 = mode == 3 ? 10 : 28; nM3 = mode == 3 ? 1 : 120; nN3 = mode == 3 ? 8 : 38; nwg = nM * nN + nM2 * nN2 + nM3 * nN3;
        nb = nb_; cut = 0; if (nb_ > 0) { const int rest = nwg - 2 * (G_ - nb_); cut = rest > 0 ? (rest + G_ - 1) / G_ : 0; } }
    __device__ __forceinline__ bool next(int i, Unit& u) const {
        const int ii = pair ? (i >> 1) : i;
        long L = (long)ii * G + c; u.qm = 15;
        if (nb > 0 && ii >= cut) { if (c < nb) return false; L = (long)cut * G + (long)(ii - cut) * (G - nb) + (c - nb); }
        if (qtail && ii == nwg / G) { L = (long)ii * G + (vcu >> 2); u.qm = 1 << (vcu & 3); if ((vcu >> 2) >= nwg % G) return false; }
        if (L >= nwg) return false;
        asm volatile("" : "+s"(u.qm));
        int wgid = (int)L; { const int q = nwg / NXCD, r = nwg % NXCD, xcd = wgid % NXCD, off = wgid / NXCD; wgid = (xcd < r ? xcd * (q + 1) : r * (q + 1) + (xcd - r) * q) + off; }
        int rM = nM, rN = nN, rect = 0;
        if (pmode >= 3 && wgid >= nM * nN) { wgid -= nM * nN; rM = nM2; rN = nN2; rect = 1; if (wgid >= nM2 * nN2) { wgid -= nM2 * nN2; rM = nM3; rN = nN3; rect = 2; } }
        const int nig = wgm * rN, gid = wgid / nig, fm = gid * wgm, gsz = (rM - fm) < wgm ? (rM - fm) : wgm;
        int pm = fm + ((wgid % nig) % gsz), pn = (wgid % nig) / gsz;
        u.sel = pair ? (i & 1) : 0;
        if (pmode == 3) {
            if (rect == 0) { pm = 16 * pm + 15; pn += 4; } else if (rect == 1) { pm += 128; pn = pn < 2 ? 4 + pn : 8 + pn; } else { pn += 10; u.sel = 1; }
        } else if (pmode == 4) {
            if (rect == 0) { pm = 16 * pm + 15; pn = pn < 4 ? pn : 2 + pn; } else if (rect == 1) { pm += 128; pn = pn < 4 ? pn : (pn < 8 ? 2 + pn : 10 + pn); } else pm += pm / 15;
        }
        u.pm = pm; u.pn = pn;
        return true;
    }
};

template <class Epi, bool ALIGN_EPI, bool SP2, bool FP8 = false>
__device__ __forceinline__ void gemm_phase(LAS unsigned char* lds, const Gemm g, const Order& S, const Epi& E) {
    const int tid = threadIdx.x, wid = __builtin_amdgcn_readfirstlane(tid >> 6), lane = tid & 63, wr = wid >> 2, wc = wid & 3, fr = lane & 15, fq = lane >> 4;
    const int K = g.K, PB = FP8 ? K : 2 * K, nt = PB / 128; const int KPA = (FP8 && g.pitchA) ? g.pitchA : K, KPB = (FP8 && g.pitchB) ? g.pitchB : K;
    unsigned voffA[2], voffB[2];
#pragma unroll
    for (int i = 0; i < 2; ++i) { int R, C; if constexpr (FP8) { stage_rc8(tid * 16 + i * 8192, R, C); } else { stage_rc(tid * 16 + i * 8192, R, C); }
        const int Rb = Epi::PERM ? ((R & ~31) + perm32(R & 31)) : R;
        if constexpr (FP8) { voffA[i] = (unsigned)(R * KPA + C); voffB[i] = (unsigned)(Rb * KPB + C); } else { voffA[i] = (unsigned)(R * K + C) * 2u; voffB[i] = (unsigned)(Rb * K + C) * 2u; } }
    const size_t kstep = (size_t)128;
    const size_t hstepA = (size_t)HALF * (FP8 ? KPA : PB), hstepB = (size_t)HALF * (FP8 ? KPB : PB);
    const size_t tstepA = 2 * hstepA, tstepB = 2 * hstepB;
    const unsigned ldsw = (unsigned)wid * 1024u;
    const int aoff = FP8 ? lds_byte8(wr * 64 + fr, fq * 32) : lds_byte(wr * 64 + fr, fq * 8), boff = FP8 ? lds_byte8(wc * 32 + fr, fq * 32) : lds_byte(wc * 32 + fr, fq * 8);
    const int aoff1 = FP8 ? lds_byte8(wr * 64 + fr, fq * 32 + 16) : 0, boff1 = FP8 ? lds_byte8(wc * 32 + fr, fq * 32 + 16) : 0;
#define PG8_SA(b, h) (((b) * 2 + (h)) * HTB)
#define PG8_SB(b, h) ((4 + (b) * 2 + (h)) * HTB)
#define PG8_STAGE(bufoff, gbase, voff) do { _Pragma("unroll") for (int _i = 0; _i < 2; ++_i) \
        __builtin_amdgcn_global_load_lds((const unsigned*)((const char*)(gbase) + (voff)[_i]), (LAS unsigned*)(lds + (bufoff) + ldsw + _i * 8192), 16, 0, 0); } while (0)
#define PG8_LDA(dst, b, h) do { _Pragma("unroll") for (int m = 0; m < 4; ++m) _Pragma("unroll") for (int k = 0; k < 2; ++k) dst[m][k] = *(const LAS bf16x8*)(lds + PG8_SA(b, h) + (FP8 ? (k ? aoff1 : aoff) : aoff + k * 1024) + m * 2048); } while (0)
#define PG8_LDB(dst, b, h) do { _Pragma("unroll") for (int n = 0; n < 2; ++n) _Pragma("unroll") for (int k = 0; k < 2; ++k) dst[n][k] = *(const LAS bf16x8*)(lds + PG8_SB(b, h) + (FP8 ? (k ? boff1 : boff) : boff + k * 1024) + n * 2048); } while (0)
#define PG8_CAT8(x) __builtin_shufflevector(__builtin_bit_cast(i32x4, (x)[0]), __builtin_bit_cast(i32x4, (x)[1]), 0, 1, 2, 3, 4, 5, 6, 7)
#define PG8_MMA(ai, bj, At, Bt) do { if (!(cur.qm & (1 << (2 * (ai) + (bj))))) break; __builtin_amdgcn_s_setprio(1); _Pragma("unroll") for (int m = 0; m < 4; ++m) _Pragma("unroll") for (int n = 0; n < 2; ++n) { \
        if constexpr (FP8) acc[ai][bj][m][n] = __builtin_amdgcn_mfma_scale_f32_16x16x128_f8f6f4(PG8_CAT8(Bt[n]), PG8_CAT8(At[m]), acc[ai][bj][m][n], 0, 0, 0, 0x7F7F7F7F, 0, 0x7F7F7F7F); \
        else { _Pragma("unroll") for (int k = 0; k < 2; ++k) acc[ai][bj][m][n] = __builtin_amdgcn_mfma_f32_16x16x32_bf16(Bt[n][k], At[m][k], acc[ai][bj][m][n], 0, 0, 0); } } __builtin_amdgcn_s_setprio(0); } while (0)
#define PG8_WAIT_V(n) asm volatile("s_waitcnt vmcnt(" #n ")" ::: "memory")
#define PG8_WAIT_L(n) asm volatile("s_waitcnt lgkmcnt(" #n ")" ::: "memory")
#define PG8_WAIT_V8X(first) do { if ((first) && nepi >= 46) PG8_WAIT_V(54); else if ((first) && nepi >= 30) PG8_WAIT_V(38); else if ((first) && nepi >= 14) PG8_WAIT_V(22); else if ((first) && nepi >= 6) PG8_WAIT_V(14); else PG8_WAIT_V(8); } while (0)
#define PG8_BAR __builtin_amdgcn_s_barrier()
#define PG8_SCHED __builtin_amdgcn_sched_barrier(0)
    Unit cur, nxt; int ui = 0, nepi = 0;
    if (!S.next(0, cur)) return;
    f32x4 acc[2][2][4][2];
#pragma unroll
    for (int a = 0; a < 2; ++a)
#pragma unroll
        for (int b = 0; b < 2; ++b)
#pragma unroll
            for (int m = 0; m < 4; ++m)
#pragma unroll
                for (int n = 0; n < 2; ++n) acc[a][b][m][n] = (f32x4){0.f, 0.f, 0.f, 0.f};
    bf16x8 At[4][2], B0[2][2], B1[2][2];
    const char* cA = (const char*)(cur.sel ? g.A1 : g.A0) + (size_t)cur.pm * tstepA; const char* cB = (const char*)(cur.sel ? g.B1 : g.B0) + (size_t)cur.pn * tstepB;
    if constexpr (SP2) {
        PG8_STAGE(PG8_SB(0, 0), cB, voffB); PG8_STAGE(PG8_SB(0, 1), cB + hstepB, voffB); PG8_STAGE(PG8_SA(0, 0), cA, voffA); PG8_STAGE(PG8_SA(0, 1), cA + hstepA, voffA);
        if (wr == 1) PG8_BAR;
        PG8_WAIT_V(2); PG8_BAR;
        PG8_STAGE(PG8_SB(1, 0), cB + kstep, voffB); PG8_STAGE(PG8_SA(1, 0), cA + kstep, voffA); PG8_STAGE(PG8_SB(1, 1), cB + hstepB + kstep, voffB);
        PG8_WAIT_V(6); PG8_BAR;
    } else {
        PG8_STAGE(PG8_SB(0, 0), cB, voffB); PG8_STAGE(PG8_SA(0, 0), cA, voffA); PG8_STAGE(PG8_SB(0, 1), cB + hstepB, voffB); PG8_STAGE(PG8_SA(0, 1), cA + hstepA, voffA);
        if (wr == 1) PG8_BAR;
        PG8_WAIT_V(4); PG8_BAR;
        PG8_STAGE(PG8_SB(1, 0), cB + kstep, voffB); PG8_STAGE(PG8_SA(1, 0), cA + kstep, voffA); PG8_STAGE(PG8_SB(1, 1), cB + hstepB + kstep, voffB);
        PG8_WAIT_V(6); PG8_BAR;
    }
    for (;;) {
        const bool has_next = S.next(ui + 1, nxt);
        const char* nA = has_next ? (const char*)(nxt.sel ? g.A1 : g.A0) + (size_t)nxt.pm * tstepA : cA; const char* nB = has_next ? (const char*)(nxt.sel ? g.B1 : g.B0) + (size_t)nxt.pn * tstepB : cB;
        for (int t = 0; t < nt; t += 2) {
            const bool last = (t == nt - 2);
            const char* a1 = cA + (size_t)(t + 1) * kstep;
            const char* a2 = last ? nA : cA + (size_t)(t + 2) * kstep; const char* b2 = last ? nB : cB + (size_t)(t + 2) * kstep;
            const char* a3 = a2 + kstep; const char* b3 = b2 + kstep;
            if constexpr (SP2) {
            PG8_LDB(B0, 0, 0); PG8_LDB(B1, 0, 1); PG8_SCHED; PG8_LDA(At, 0, 0); PG8_STAGE(PG8_SA(1, 1), a1 + hstepA, voffA);
            PG8_WAIT_V8X(t == 0); PG8_WAIT_L(0); PG8_BAR; PG8_MMA(0, 0, At, B0); PG8_MMA(0, 1, At, B1); PG8_BAR; PG8_SCHED;
            PG8_LDA(At, 0, 1); PG8_STAGE(PG8_SB(0, 0), b2, voffB); PG8_STAGE(PG8_SB(0, 1), b2 + hstepB, voffB); PG8_STAGE(PG8_SA(0, 0), a2, voffA);
            PG8_WAIT_V8X(t == 0); PG8_WAIT_L(0); PG8_BAR; PG8_MMA(1, 0, At, B0); PG8_MMA(1, 1, At, B1); PG8_BAR; PG8_SCHED;
            PG8_LDB(B0, 1, 0); PG8_LDB(B1, 1, 1); PG8_SCHED; PG8_LDA(At, 1, 0); PG8_STAGE(PG8_SA(0, 1), a2 + hstepA, voffA);
            PG8_WAIT_V(8); PG8_WAIT_L(0); PG8_BAR; PG8_MMA(0, 0, At, B0); PG8_MMA(0, 1, At, B1); PG8_BAR; PG8_SCHED;
            PG8_LDA(At, 1, 1); PG8_STAGE(PG8_SB(1, 0), b3, voffB); PG8_STAGE(PG8_SB(1, 1), b3 + hstepB, voffB); PG8_STAGE(PG8_SA(1, 0), a3, voffA);
            PG8_WAIT_V(8); PG8_WAIT_L(0); PG8_BAR; PG8_MMA(1, 0, At, B0); PG8_MMA(1, 1, At, B1); PG8_BAR; PG8_SCHED;
            } else {
            PG8_LDB(B0, 0, 0); PG8_SCHED; PG8_LDA(At, 0, 0); PG8_STAGE(PG8_SA(1, 1), a1 + hstepA, voffA);
            PG8_WAIT_L(8); PG8_BAR; PG8_WAIT_L(0); PG8_MMA(0, 0, At, B0); PG8_BAR; PG8_SCHED;
            PG8_LDB(B1, 0, 1); PG8_STAGE(PG8_SB(0, 0), b2, voffB);
            PG8_BAR; PG8_WAIT_L(0); PG8_MMA(0, 1, At, B1); PG8_BAR;
            PG8_LDA(At, 0, 1); PG8_STAGE(PG8_SA(0, 0), a2, voffA);
            PG8_BAR; PG8_WAIT_L(0); PG8_MMA(1, 0, At, B0); PG8_BAR; PG8_SCHED;
            PG8_STAGE(PG8_SB(0, 1), b2 + hstepB, voffB);
            PG8_WAIT_V(6); PG8_BAR; PG8_MMA(1, 1, At, B1); PG8_BAR;
            PG8_LDB(B0, 1, 0); PG8_SCHED; PG8_LDA(At, 1, 0); PG8_STAGE(PG8_SA(0, 1), a2 + hstepA, voffA);
            PG8_WAIT_L(8); PG8_BAR; PG8_WAIT_L(0); PG8_MMA(0, 0, At, B0); PG8_BAR; PG8_SCHED;
            PG8_LDB(B1, 1, 1); PG8_STAGE(PG8_SB(1, 0), b3, voffB);
            PG8_BAR; PG8_WAIT_L(0); PG8_MMA(0, 1, At, B1); PG8_BAR;
            PG8_LDA(At, 1, 1); PG8_STAGE(PG8_SA(1, 0), a3, voffA);
            PG8_BAR; PG8_WAIT_L(0); PG8_MMA(1, 0, At, B0); PG8_BAR; PG8_SCHED;
            PG8_STAGE(PG8_SB(1, 1), b3 + hstepB, voffB);
            PG8_WAIT_V(6); PG8_BAR; PG8_MMA(1, 1, At, B1); PG8_BAR;
            }
        }
        if constexpr (ALIGN_EPI) { if (wr == 0) PG8_BAR; }
        const bool keep = E(acc, cur, wr, wc, fr, fq); nepi = Epi::nvm(cur);
        if (!has_next) break;
        if (!keep) {
#pragma unroll
        for (int a = 0; a < 2; ++a)
#pragma unroll
            for (int b = 0; b < 2; ++b)
#pragma unroll
                for (int m = 0; m < 4; ++m)
#pragma unroll
                    for (int n = 0; n < 2; ++n) acc[a][b][m][n] = (f32x4){0.f, 0.f, 0.f, 0.f};
        }
        cur = nxt; cA = nA; cB = nB; ++ui;
        if constexpr (ALIGN_EPI) { if (wr == 1) PG8_BAR; }
    }
    PG8_WAIT_V(0);
    if constexpr (!ALIGN_EPI) { if (wr == 0) PG8_BAR; }
    PG8_BAR;
#undef PG8_SA
#undef PG8_SB
#undef PG8_STAGE
#undef PG8_LDA
#undef PG8_LDB
#undef PG8_MMA
#undef PG8_CAT8
#undef PG8_WAIT_V
#undef PG8_WAIT_L
#undef PG8_WAIT_V8X
#undef PG8_BAR
#undef PG8_SCHED
}
}

template <bool F8> struct Epi1 {
    static constexpr bool PERM = true;
    bf16_t *Qb, *Kb, *Vb, *SGA, *U, *SGB, *SMG; const float* ropec; const float* ropes; bf16_t* UX;
    static constexpr float asc = F8 ? 1.0f / W8_SCALE : 1.0f;
    static __device__ __forceinline__ int nvm(const pg8::Unit& u) { return ((u.pn >= 10 && u.pn < 18) || u.pn >= 22) ? 6 : 14; }
    __device__ __forceinline__ bool operator()(f32x4 (&acc)[2][2][4][2], const pg8::Unit& u, int wr, int wc, int fr, int fq) const {
        const int pn = u.pn, pm = u.pm;
        int rt = wr * 64 + fr;
        asm volatile("" : "+v"(rt));
        asm volatile("" : "+v"(fq));
        if (F8 ? pn < 5 : pn == 4) {
            const bool isq = pn < 4;
            const int head = isq ? (4 * pn + wc) : wc;
            const int ldc = isq ? NQ : NKV; const float sc = (isq ? QSCALE : 1.0f) * asc;
            GAS bf16_t* st = (GAS bf16_t*)(isq ? Qb : Kb) + ((size_t)pm * 256 + rt) * ldc + head * 64 + 8 * fq;
            const bool samp = pm >= 128;
            const GAS float* rc = (const GAS float*)ropec + (size_t)(samp ? PAST + fr : ((pm & 15) << 8) + rt) * 32 + 8 * fq;
            const GAS float* rs = (const GAS float*)ropes + (size_t)(samp ? PAST + fr : ((pm & 15) << 8) + rt) * 32 + 8 * fq;
            const int tstep = samp ? 0 : 1;
            f32x4 cs[2][4];
#define EPI1_LOAD(g, buf) do { const int o_ = samp ? ((g) & 1) * 16 * 32 : 0; cs[buf][0] = *(const GAS f32x4*)(rc + o_); cs[buf][1] = *(const GAS f32x4*)(rc + o_ + 4); cs[buf][2] = *(const GAS f32x4*)(rs + o_); cs[buf][3] = *(const GAS f32x4*)(rs + o_ + 4); \
            rc += tstep * (((g) & 3) == 3 ? 80 : 16) * 32; rs += tstep * (((g) & 3) == 3 ? 80 : 16) * 32; asm volatile("" : "+v"(rc), "+v"(rs)); } while (0)
            EPI1_LOAD(0, 0);
#pragma unroll
            for (int g = 0; g < 8; ++g) {
                if (g + 1 < 8) EPI1_LOAD(g + 1, (g + 1) & 1);
                const int ai = g >> 2, m = g & 3;
                const f32x4 c0 = cs[g & 1][0], c1 = cs[g & 1][1], s0 = cs[g & 1][2], s1 = cs[g & 1][3];
                const f32x4 x10 = acc[ai][0][m][0], x11 = acc[ai][0][m][1], x20 = acc[ai][1][m][0], x21 = acc[ai][1][m][1];
                const f32x4 o10 = (x10 * c0 - x20 * s0) * sc, o11 = (x11 * c1 - x21 * s1) * sc, o20 = (x20 * c0 + x10 * s0) * sc, o21 = (x21 * c1 + x11 * s1) * sc;
                *(GAS u32x4*)st = pack8(o10, o11); *(GAS u32x4*)(st + 32) = pack8(o20, o21);
                st += ((g & 3) == 3 ? 80 : 16) * ldc; asm volatile("" : "+v"(st));
            }
#undef EPI1_LOAD
        } else if (pn >= 10 && pn < 18) {
            GAS bf16_t* st = (GAS bf16_t*)((!F8 && u.sel) ? UX : U) + ((size_t)pm * 256 + rt) * CD + (pn - 10) * 128 + wc * 32 + 8 * fq;
#pragma unroll
            for (int g = 0; g < 8; ++g) {
                const int ai = g >> 2, m = g & 3;
                f32x4 v0 = acc[ai][0][m][0], v1 = acc[ai][0][m][1]; const f32x4 g0 = acc[ai][1][m][0], g1 = acc[ai][1][m][1];
#pragma unroll
                for (int i = 0; i < 4; ++i) { v0[i] *= asc * fast_sigmoid(g0[i] * asc); v1[i] *= asc * fast_sigmoid(g1[i] * asc); }
                *(GAS u32x4*)st = pack8(v0, v1);
                st += ((g & 3) == 3 ? 80 : 16) * CD; asm volatile("" : "+v"(st));
            }
        } else if (F8 && pn >= 22) {
            unsigned lo_ = (unsigned)rt * 4096u + (unsigned)(wc * 64 + fq * 16); asm volatile("" : "+v"(lo_));
            GAS unsigned char* st = (GAS unsigned char*)SMG + ((size_t)pm * 256 * 4096 + (size_t)(pn - 22) * 256) + lo_;
            const float nl2 = -LOG2E * asc;
#pragma unroll
            for (int g = 0; g < 8; ++g) {
                const int ai = g >> 2, m = g & 3;
                f32x4 sa0, sa1, sb0, sb1; const f32x4 a0 = acc[ai][0][m][0], a1 = acc[ai][0][m][1], g0 = acc[ai][1][m][0], g1 = acc[ai][1][m][1];
#pragma unroll
                for (int i = 0; i < 4; ++i) {
                    sa0[i] = __builtin_amdgcn_rcpf(1.0f + __builtin_amdgcn_exp2f(nl2 * a0[i])); sa1[i] = __builtin_amdgcn_rcpf(1.0f + __builtin_amdgcn_exp2f(nl2 * a1[i]));
                    sb0[i] = __builtin_amdgcn_rcpf(1.0f + __builtin_amdgcn_exp2f(nl2 * g0[i])); sb1[i] = __builtin_amdgcn_rcpf(1.0f + __builtin_amdgcn_exp2f(nl2 * g1[i]));
                }
                *(GAS u32x4*)st = (u32x4){pack4_u8(sa0, 0u), pack4_u8(sa1, 0u), pack4_u8(sb0, 1u), pack4_u8(sb1, 1u)};
                st += ((g & 3) == 3 ? 80 : 16) * 4096; asm volatile("" : "+v"(st));
            }
        } else {
            bf16_t* d0; int ldc, ct, mode;
            if (!F8 || pn == 5) { d0 = Vb; ldc = NKV; ct = 0; mode = 0; }
            else if (pn < 10) { d0 = SGA; ldc = NQ; ct = pn - 6; mode = 1; }
            else { d0 = SGB; ldc = CD; ct = pn - 18; mode = 1; }
            GAS bf16_t* st = (GAS bf16_t*)d0 + ((size_t)pm * 256 + rt) * ldc + ct * 256 + wc * 32 + 8 * fq;
#pragma unroll
            for (int g = 0; g < 8; ++g) {
                const int ai = g >> 2, m = g & 3;
#pragma unroll
                for (int bj = 0; bj < 2; ++bj) {
                    f32x4 v0 = acc[ai][bj][m][0], v1 = acc[ai][bj][m][1];
                    v0 *= asc; v1 *= asc;
                    if (mode != 0) {
#pragma unroll
                        for (int i = 0; i < 4; ++i) { v0[i] *= fast_sigmoid(v0[i]); v1[i] *= fast_sigmoid(v1[i]); }
                    }
                    *(GAS u32x4*)(st + bj * 128) = pack8(v0, v1);
                }
                st += ((g & 3) == 3 ? 80 : 16) * ldc; asm volatile("" : "+v"(st));
            }
        }
        return false;
    }
};
struct Epi2 {
    static constexpr bool PERM = true;
    static __device__ __forceinline__ int nvm(const pg8::Unit& u) { return 14; }
    __device__ __forceinline__ void touch(const pg8::Unit&, int, int, LAS unsigned char*) const {}
    bf16_t* MG; const bf16_t* SMG;
    __device__ __forceinline__ bool operator()(f32x4 (&acc)[2][2][4][2], const pg8::Unit& u, int wr, int wc, int fr, int fq) const {
        const int rt = wr * 64 + fr; const int c0 = u.pn * 256 + wc * 32 + 8 * fq;
        const bool fin = u.sel != 0;
        const GAS unsigned char* ls = (const GAS unsigned char*)SMG + ((size_t)u.pm * 256 + rt) * 4096 + u.pn * 512 + wc * 128 + fq * 32;
        GAS unsigned char* st = (GAS unsigned char*)MG + ((size_t)u.pm * 256 + rt) * PK_MG + u.pn * 256 + wc * 64 + fq * 16;
        constexpr int DEPTH = 4;
        u32x4 sg[DEPTH][2];
#define EPI2_LOAD(g, buf) do { sg[buf][0] = *(const GAS u32x4*)ls; sg[buf][1] = *(const GAS u32x4*)(ls + 16); ls += (((g) & 3) == 3 ? 80 : 16) * 4096; asm volatile("" : "+v"(ls)); } while (0)
#pragma unroll
        for (int g = 0; g < DEPTH - 1; ++g) EPI2_LOAD(g, g);
#pragma unroll
        for (int g = 0; g < 8; ++g) {
            if (g + DEPTH - 1 < 8) EPI2_LOAD(g + DEPTH - 1, (g + DEPTH - 1) % DEPTH);
            const int ai = g >> 2, m = g & 3;
            u32x2 o2[2];
#pragma unroll
            for (int bj = 0; bj < 2; ++bj) {
                const u32x4 s4 = sg[g % DEPTH][bj];
                f32x4 v0 = acc[ai][bj][m][0], v1 = acc[ai][bj][m][1];
                const f32x4 b0 = unpack4_u8(s4.z), b1 = unpack4_u8(s4.w);
                if (fin) {
                    constexpr float fs = MG8_SCALE / (A8_SCALE * W8_SCALE * 255.0f);
                    o2[bj] = pack8_fp8(v0 * b0 * fs, v1 * b1 * fs);
                } else {
                    const f32x4 a0 = unpack4_u8(s4.x), a1 = unpack4_u8(s4.y);
#pragma unroll
                    for (int i = 0; i < 4; ++i) { v0[i] *= a0[i] * __builtin_amdgcn_rcpf(b0[i]); v1[i] *= a1[i] * __builtin_amdgcn_rcpf(b1[i]); }
                    acc[ai][bj][m][0] = v0; acc[ai][bj][m][1] = v1;
                }
            }
            if (fin) { const int q2 = (u.qm >> (2 * ai)) & 3;
                if (q2 == 3) *(GAS u32x4*)st = (u32x4){o2[0].x, o2[0].y, o2[1].x, o2[1].y}; else if (q2 == 1) *(GAS u32x2*)st = o2[0]; else if (q2 == 2) *(GAS u32x2*)(st + 8) = o2[1]; }
            st += ((g & 3) == 3 ? 80 : 16) * PK_MG; asm volatile("" : "+v"(st));
        }
#undef EPI2_LOAD
        return !fin;
    }
};
struct Epi3 {
    static constexpr bool PERM = true;
    static __device__ __forceinline__ int nvm(const pg8::Unit& u) { return u.qm == 15 ? 14 : 2; }
    const float* gate; bf16_t* ybr;
    __device__ __forceinline__ bool operator()(f32x4 (&acc)[2][2][4][2], const pg8::Unit& u, int wr, int wc, int fr, int fq) const {
        const int rt = wr * 64 + fr; const int c0 = u.pn * 256 + wc * 32 + 8 * fq;
        const bool samp = u.pm >= 128;
        const GAS float* gb = (const GAS float*)gate + (size_t)(samp ? NB_P + (u.pm - 128) * 8 + 2 * wr : (u.pm >> 4)) * DM + c0;
        GAS bf16_t* sy = (GAS bf16_t*)ybr + ((size_t)u.pm * 256 + rt) * DM + c0;
        f32x4 gv[4];
#define EPI3_GATE(g) do { const GAS float* gp_ = gb + (samp ? (4 * ((g) >> 2) + (((g) & 3) >> 1)) * DM : 0); _Pragma("unroll") for (int q_ = 0; q_ < 4; ++q_) gv[q_] = *(const GAS f32x4*)(gp_ + (q_ >> 1) * 128 + (q_ & 1) * 4) * (1.0f / (W8_SCALE * MG8_SCALE)); } while (0)
        EPI3_GATE(0);
#pragma unroll
        for (int g = 0; g < 8; ++g) {
            if (g > 0 && (g & 1) == 0 && samp) EPI3_GATE(g);
            const int ai = g >> 2, m = g & 3;
#pragma unroll
            for (int bj = 0; bj < 2; ++bj)
                if (u.qm & (1 << (2 * ai + bj))) *(GAS u32x4*)(sy + bj * 128) = pack8(gv[2 * bj] * acc[ai][bj][m][0], gv[2 * bj + 1] * acc[ai][bj][m][1]);
            sy += ((g & 3) == 3 ? 80 : 16) * DM; asm volatile("" : "+v"(sy));
        }
#undef EPI3_GATE
        return false;
    }
};

typedef GAS unsigned gu32;
#define RLX_AGENT __ATOMIC_RELAXED, __HIP_MEMORY_SCOPE_AGENT
#define XB_TMO      128
#define XB_XCNT(j)  (256  + 64 * (j))
#define XB_XSUB(j)  (1280 + 64 * (j))
#define XB_XGEN(j)  (2304 + 64 * (j))
#define XB_TOP      3328
#define XB_TOPGEN   3392
#define XCD_BAR_WORDS 3456
#define XB_SPIN_CAP (1u << 18)
__device__ __forceinline__ unsigned xb_ld(unsigned* p)              { return __hip_atomic_load(p, __ATOMIC_RELAXED, __HIP_MEMORY_SCOPE_AGENT); }
__device__ __forceinline__ unsigned xb_add(unsigned* p, unsigned v) { return __hip_atomic_fetch_add(p, v, __ATOMIC_RELAXED, __HIP_MEMORY_SCOPE_AGENT); }
__device__ __forceinline__ unsigned xb_xcc_id() { return (unsigned)__builtin_amdgcn_s_getreg((3 << 11) | 20) & 0xFu; }
#define XB_SPIN(cond, bar) do { unsigned _sp = 0; while (cond) { __builtin_amdgcn_s_sleep(1); \
    if ((++_sp & 255u) == 0u) { if (xb_ld(&(bar)[XB_TMO])) break; if (_sp > XB_SPIN_CAP) { atomicAdd(&(bar)[XB_TMO], 1u); break; } } } } while (0)
struct XcdBarrier { unsigned* bar; unsigned x; volatile LAS unsigned* st; };
__device__ __forceinline__ XcdBarrier xcd_barrier_post(unsigned* bar, volatile LAS unsigned* st) {
    XcdBarrier b; b.bar = bar; b.x = xb_xcc_id(); b.st = st;
    if (threadIdx.x == 0) (void)xb_add(&bar[XB_XCNT(b.x)], 1u);
    return b;
}
__device__ __forceinline__ void xcd_barrier_complete(unsigned* bar, unsigned x, unsigned& nloc, unsigned& nx) {
    const unsigned G = gridDim.x * gridDim.y * gridDim.z;
    unsigned sum, cnt, mine, sp = 0u;
    for (;;) {
        sum = 0u; cnt = 0u; mine = 0u;
#pragma unroll
        for (unsigned j = 0; j < 16; ++j) { const unsigned c = xb_ld(&bar[XB_XCNT(j)]); sum += c; cnt += (c > 0u) ? 1u : 0u; mine = (j == x) ? c : mine; }
        if (sum == G) break;
        __builtin_amdgcn_s_sleep(1);
        if ((++sp & 255u) == 0u) { if (xb_ld(&bar[XB_TMO])) break; if (sp > XB_SPIN_CAP) { atomicAdd(&bar[XB_TMO], 1u); break; } }
    }
    nloc = mine > 0u ? mine : 1u; nx = cnt > 0u ? cnt : 1u;
}
__device__ __forceinline__ void xcd_barrier(const XcdBarrier& b) {
    asm volatile("s_waitcnt vmcnt(0)" ::: "memory");
    __syncthreads();
    if (threadIdx.x == 0) {
        unsigned* bar = b.bar;
        __builtin_amdgcn_s_waitcnt(0);
        unsigned nloc = b.st[0], nx = b.st[1];
        if (nloc == 0u) { xcd_barrier_complete(bar, b.x, nloc, nx); b.st[0] = nloc; b.st[1] = nx; }
        const unsigned old = xb_add(&bar[XB_XSUB(b.x)], 1u);
        const unsigned gen = old / nloc;
        if (old + 1u == (gen + 1u) * nloc) {
            __builtin_amdgcn_fence(__ATOMIC_RELEASE, "agent");
            asm volatile("s_waitcnt vmcnt(0)" ::: "memory");
            const unsigned og = xb_add(&bar[XB_TOP], 1u);
            const unsigned tg = og / nx;
            if (og + 1u == (tg + 1u) * nx) xb_add(&bar[XB_TOPGEN], 1u);
            else XB_SPIN(xb_ld(&bar[XB_TOPGEN]) == tg, bar);
            __builtin_amdgcn_fence(__ATOMIC_ACQUIRE, "agent");
            xb_add(&bar[XB_XGEN(b.x)], 1u);
            asm volatile("s_waitcnt vmcnt(0)" ::: "memory");
        } else {
            XB_SPIN(xb_ld(&bar[XB_XGEN(b.x)]) == gen, bar);
            __builtin_amdgcn_fence(__ATOMIC_ACQUIRE, "agent");
            asm volatile("s_waitcnt vmcnt(0)" ::: "memory");
        }
    }
    __syncthreads();
}

__device__ __forceinline__ void xcd_barrier_arrive(const XcdBarrier& b) {
    asm volatile("s_waitcnt vmcnt(0)" ::: "memory");
    __syncthreads();
    if (threadIdx.x == 0) {
        unsigned* bar = b.bar;
        __builtin_amdgcn_s_waitcnt(0);
        unsigned nloc = b.st[0], nx = b.st[1];
        if (nloc == 0u) { xcd_barrier_complete(bar, b.x, nloc, nx); b.st[0] = nloc; b.st[1] = nx; }
        const unsigned old = xb_add(&bar[XB_XSUB(b.x)], 1u);
        const unsigned gen = old / nloc;
        unsigned tg = 0u, last = 0u, toplast = 0u;
        if (old + 1u == (gen + 1u) * nloc) {
            last = 1u;
            __builtin_amdgcn_fence(__ATOMIC_RELEASE, "agent");
            asm volatile("s_waitcnt vmcnt(0)" ::: "memory");
            const unsigned og = xb_add(&bar[XB_TOP], 1u);
            tg = og / nx;
            if (og + 1u == (tg + 1u) * nx) { toplast = 1u; xb_add(&bar[XB_TOPGEN], 1u); }
        }
        b.st[2] = gen; b.st[3] = tg; b.st[4] = last; b.st[5] = toplast;
    }
}
__device__ __forceinline__ void xcd_barrier_wait(const XcdBarrier& b) {
    asm volatile("s_waitcnt vmcnt(0)" ::: "memory");
    __syncthreads();
    if (threadIdx.x == 0) {
        unsigned* bar = b.bar;
        const unsigned gen = b.st[2], tg = b.st[3], last = b.st[4], toplast = b.st[5];
        if (last) {
            if (!toplast) XB_SPIN(xb_ld(&bar[XB_TOPGEN]) == tg, bar);
            __builtin_amdgcn_fence(__ATOMIC_ACQUIRE, "agent");
            xb_add(&bar[XB_XGEN(b.x)], 1u);
            asm volatile("s_waitcnt vmcnt(0)" ::: "memory");
        } else {
            XB_SPIN(xb_ld(&bar[XB_XGEN(b.x)]) == gen, bar);
            __builtin_amdgcn_fence(__ATOMIC_ACQUIRE, "agent");
            asm volatile("s_waitcnt vmcnt(0)" ::: "memory");
        }
    }
    __syncthreads();
}

struct Frame {
    LAS unsigned char* lds;
    int tid, lane, wave, vcu, G;
    const float *xp, *xs, *cp, *cs, *cache_k, *cache_v, *state_conv, *norm_g, *w_ada, *b_ada, *w_in, *sinks, *w_dw, *b_dw, *ln_g, *ln_b, *w_pa, *w_pb, *w_out, *final_g;
    float* out;
    float *gate, *ropec, *ropes, *rss, *part;
    unsigned char *W8, *H8;
    bf16_t *Win_t, *Wa_t, *Wb_t, *Wo_t, *H, *Qb, *Kb, *Vb, *SGA, *U, *SGB, *SMG, *A1, *A2, *UH, *ZROW, *UX, *HG;
};

__constant__ double INV_FREQ[32] = {1.0, 0.7498942093324559, 0.5623413251903491, 0.4216965034285822, 0.31622776601683794, 0.23713737056616552, 0.1778279410038923, 0.1333521432163324,
    0.1, 0.07498942093324558, 0.05623413251903491, 0.042169650342858224, 0.03162277660168379, 0.023713737056616554, 0.01778279410038923, 0.01333521432163324,
    0.01, 0.007498942093324558, 0.005623413251903491, 0.004216965034285823, 0.0031622776601683794, 0.0023713737056616554, 0.0017782794100389228, 0.001333521432163324,
    0.001, 0.0007498942093324559, 0.0005623413251903491, 0.00042169650342858224, 0.00031622776601683794, 0.00023713737056616554, 0.00017782794100389227, 0.0001333521432163324};

__host__ __device__ __forceinline__ bool tile_w8(int tile) { return true; }
__host__ __device__ __forceinline__ bool tile_wb(int tile) { return tile == 4 || tile == 5 || (tile >= 10 && tile < 18); }
__device__ __forceinline__ int colmap(int n) {
    const int tile = n >> 8, j = n & 255, bj = j >> 7, x = j & 127;
    if (tile < 4) return (4 * tile + (x >> 5)) * 64 + bj * 32 + (x & 31);
    if (tile == 4) return NQ + (x >> 5) * 64 + bj * 32 + (x & 31);
    if (tile >= 10 && tile < 18) return 2560 + bj * 1024 + 128 * (tile - 10) + x;
    if (tile >= 22) return 5632 + bj * DM + 128 * (tile - 22) + x;
    return n;
}
struct TrBlk { f32x4 a, b, c, d, e, f, g, h; };
__device__ __forceinline__ void tr_load(const float* W, int N, int k0, int n0s, int lane, TrBlk& v, bool permn = false) {
    const GAS float* p = (const GAS float*)W + (size_t)(k0 + (lane >> 3)) * N + n0s + (permn ? 16 * ((lane & 7) >> 1) + 4 * (lane & 1) : 4 * (lane & 7));
    v.a = *(const GAS f32x4*)p; v.b = *(const GAS f32x4*)(p + (size_t)8 * N); v.c = *(const GAS f32x4*)(p + (size_t)16 * N); v.d = *(const GAS f32x4*)(p + (size_t)24 * N);
    v.e = *(const GAS f32x4*)(p + (size_t)32 * N); v.f = *(const GAS f32x4*)(p + (size_t)40 * N); v.g = *(const GAS f32x4*)(p + (size_t)48 * N); v.h = *(const GAS f32x4*)(p + (size_t)56 * N);
}
__device__ __forceinline__ void tr_scatter(const TrBlk& v, LAS float* scr, int lane) {
    LAS float* q = scr + (lane >> 3) * 33 + 4 * (lane & 7);
#define TR_PUT(x, i) do { q[(8 * (i)) * 33] = (x)[0]; q[(8 * (i)) * 33 + 1] = (x)[1]; q[(8 * (i)) * 33 + 2] = (x)[2]; q[(8 * (i)) * 33 + 3] = (x)[3]; } while (0)
    TR_PUT(v.a, 0); TR_PUT(v.b, 1); TR_PUT(v.c, 2); TR_PUT(v.d, 3); TR_PUT(v.e, 4); TR_PUT(v.f, 5); TR_PUT(v.g, 6); TR_PUT(v.h, 7);
#undef TR_PUT
    LDS_WAIT(); asm volatile("" ::: "memory");
}
__device__ __forceinline__ void transpose_item(int K, bf16_t* WT, int k0, int n0d, LAS float* scr, int lane) {
    const int c = lane & 7;
#pragma unroll
    for (int j = 0; j < 4; ++j) { const int n = (lane >> 3) + 8 * j; const LAS float* s = scr + (8 * c) * 33 + n;
        u32x4 o; o.x = cvt_pk_bf16(s[0 * 33], s[1 * 33]); o.y = cvt_pk_bf16(s[2 * 33], s[3 * 33]); o.z = cvt_pk_bf16(s[4 * 33], s[5 * 33]); o.w = cvt_pk_bf16(s[6 * 33], s[7 * 33]);
        *(GAS u32x4*)(WT + (size_t)(n0d + n) * K + k0 + 8 * c) = o; }
    LDS_WAIT(); asm volatile("" ::: "memory");
}

__device__ __forceinline__ void transpose_item8(int KPITCH, unsigned char* WT, int k0, int n0d, float scale, LAS float* scr, int lane) {
#pragma unroll
    for (int j = 0; j < 2; ++j) { const int cid = lane + 64 * j, n = cid >> 2, c = cid & 3; const LAS float* sp = scr + (16 * c) * 33 + n;
        f32x4 a, b, c4, d;
#pragma unroll
        for (int i = 0; i < 4; ++i) { a[i] = sp[i * 33] * scale; b[i] = sp[(4 + i) * 33] * scale; c4[i] = sp[(8 + i) * 33] * scale; d[i] = sp[(12 + i) * 33] * scale; }
        const u32x2 lo = pack8_fp8(a, b), hi = pack8_fp8(c4, d);
        *(GAS u32x4*)(WT + (size_t)(n0d + n) * KPITCH + k0 + 16 * c) = (u32x4){lo.x, lo.y, hi.x, hi.y}; }
    LDS_WAIT(); asm volatile("" ::: "memory");
}

__device__ __forceinline__ void p0_prologue(Frame& F) {
    LAS float* scr = (LAS float*)(F.lds + RING_OFF + F.wave * 16384);
    const int gw = F.vcu * NWAVES + F.wave, NGW = F.G * NWAVES, lane = F.lane;
    {
        const int n31 = lane & 31, kh = lane >> 5;
        for (int it = gw; it < KS_ADA * (MOD_N / 32); it += NGW) {
            const int ks = it / (MOD_N / 32), nb = it % (MOD_N / 32), n = nb * 32 + n31;
            f32x16 acc0, acc1;
#pragma unroll
            for (int r = 0; r < 16; ++r) { acc0[r] = 0.f; acc1[r] = 0.f; }
            constexpr int NHF = DM / KS_ADA / 64;
            static_assert(NHF % 2 == 0, "adaLN k chunks come in pairs");
            float wb[2][32], cv[NMOD];
            const GAS float* wp = (const GAS float*)F.w_ada + (size_t)(ks * (DM / KS_ADA) + 8 * kh) * MOD_N + n;
            const GAS float* cpp_ = (const GAS float*)F.cp + ks * (DM / KS_ADA) + lane; const GAS float* csp_ = (const GAS float*)F.cs + ks * (DM / KS_ADA) + lane;
#define ADA_LOADW(buf_) do { _Pragma("unroll") for (int kp_ = 0; kp_ < 32; ++kp_) { wb[buf_][kp_] = *wp; wp += ((kp_ & 7) == 7 ? 9 : 1) * MOD_N; asm volatile("" : "+v"(wp)); } } while (0)
#define ADA_LOADC() do { _Pragma("unroll") for (int r_ = 0; r_ < NMOD; ++r_) cv[r_] = (r_ < NB_P) ? cpp_[r_ * DM] : csp_[(r_ - NB_P) * DM]; cpp_ += 64; csp_ += 64; asm volatile("" : "+v"(cpp_), "+v"(csp_)); } while (0)
#define ADA_STAGE() do { _Pragma("unroll") for (int r_ = 0; r_ < NMOD; ++r_) scr[lane * 41 + r_] = cv[r_] * fast_sigmoid(cv[r_]); LDS_WAIT(); asm volatile("" ::: "memory"); } while (0)
#define ADA_MMA(buf_) do { _Pragma("unroll") for (int s_ = 0; s_ < 4; ++s_) { u32x4 a0_, a1_, b_; \
                    _Pragma("unroll") for (int i_ = 0; i_ < 4; ++i_) { const LAS float* sp_ = scr + (16 * s_ + 8 * kh + 2 * i_) * 41 + n31; \
                        a0_[i_] = cvt_pk_bf16(sp_[0], sp_[41]); a1_[i_] = n31 < 8 ? cvt_pk_bf16(sp_[32], sp_[41 + 32]) : 0u; b_[i_] = cvt_pk_bf16(wb[buf_][8 * s_ + 2 * i_], wb[buf_][8 * s_ + 2 * i_ + 1]); } \
                    acc0 = __builtin_amdgcn_mfma_f32_32x32x16_bf16(__builtin_bit_cast(bf16x8, a0_), __builtin_bit_cast(bf16x8, b_), acc0, 0, 0, 0); \
                    acc1 = __builtin_amdgcn_mfma_f32_32x32x16_bf16(__builtin_bit_cast(bf16x8, a1_), __builtin_bit_cast(bf16x8, b_), acc1, 0, 0, 0); } \
                LDS_WAIT(); asm volatile("" ::: "memory"); } while (0)
            ADA_LOADW(0); ADA_LOADC();
#pragma unroll 1
            for (int hf = 0; hf < NHF; hf += 2) {
                ADA_STAGE(); ADA_LOADW(1); ADA_LOADC(); ADA_MMA(0);
                ADA_STAGE(); if (hf + 2 < NHF) { ADA_LOADW(0); ADA_LOADC(); } ADA_MMA(1);
            }
#undef ADA_LOADW
#undef ADA_LOADC
#undef ADA_STAGE
#undef ADA_MMA
            GAS float* pp = (GAS float*)F.part + (size_t)ks * NMOD * MOD_N + n;
#pragma unroll
            for (int r = 0; r < 16; ++r) pp[(size_t)((r & 3) + 8 * (r >> 2) + 4 * kh) * MOD_N] = acc0[r];
#pragma unroll
            for (int r = 0; r < 4; ++r) pp[(size_t)(32 + r + 4 * kh) * MOD_N] = acc1[r];
        }
    }
}


__device__ __forceinline__ void p2_fill(Frame& F, int idx, int nfill, int part) {
    LAS float* scr = (LAS float*)(F.lds + RING_OFF + F.wave * 16384);
    const int gw = idx * NWAVES + F.wave, NGW = nfill * NWAVES, lane = F.lane, tid = F.tid;
    constexpr int I_PA = (NQ / 64) * (DM / 32), I_PB = (CD / 64) * (DM / 32), I_WO = (DM / 64) * (DM / 32);
    {
        TrBlk v;
        const float* wpa_ = F.w_pa; const float* wpb_ = F.w_pb; const float* wo_ = F.w_out; asm volatile("" : "+s"(wpa_), "+s"(wpb_), "+s"(wo_));
#define P2F_SRC(it) ((it) < I_PA ? wpa_ : ((it) < I_PA + I_PB ? wpb_ : wo_))
#define P2F_REL(it) ((it) < I_PA ? (it) : ((it) < I_PA + I_PB ? (it) - I_PA : (it) - I_PA - I_PB))
#define P2F_N0S(it, nb) ((it) < I_PA + I_PB ? ((nb) >> 3) * 256 + 64 * ((nb) & 3) + 8 * (((nb) & 7) >> 2) : 32 * (nb))
        const int it1 = part == 0 ? I_PA + I_PB : I_PA + I_PB + I_WO;
        int it = (part == 0 ? 0 : I_PA + I_PB) + gw; bool have = it < it1;
        if (have) { const int r = P2F_REL(it); tr_load(P2F_SRC(it), DM, 64 * (r / (DM / 32)), P2F_N0S(it, r % (DM / 32)), lane, v, (it) < I_PA + I_PB); }
        while (have) {
            const int cur = it; it += NGW;
            tr_scatter(v, scr, lane);
            const bool nxt = it < it1;
            if (nxt) { const int r = P2F_REL(it); tr_load(P2F_SRC(it), DM, 64 * (r / (DM / 32)), P2F_N0S(it, r % (DM / 32)), lane, v, (it) < I_PA + I_PB); }
            const int r = P2F_REL(cur), kb = r / (DM / 32), nb = r % (DM / 32);
            if (cur < I_PA) transpose_item8(PK_WAB, (unsigned char*)F.Wa_t, 64 * kb, 32 * nb, W8_SCALE, scr, lane);
            else if (cur < I_PA + I_PB) transpose_item8(PK_WAB, (unsigned char*)F.Wb_t, 64 * kb, 32 * nb, W8_SCALE, scr, lane);
            else transpose_item8(PK_WO, (unsigned char*)F.Wo_t, 64 * kb, 32 * nb, W8_SCALE, scr, lane);
            have = nxt;
        }
    }
    if (part == 0) return;
    for (int bi = idx; bi < NMOD; bi += nfill) {
        const int k = 4 * tid;
        f32x4 a = *(const GAS f32x4*)(F.b_ada + 2 * DM + k);
#pragma unroll
        for (int ks = 0; ks < KS_ADA; ++ks) a += *(const GAS f32x4*)(F.part + ((size_t)ks * NMOD + bi) * MOD_N + 2 * DM + k);
        *(GAS f32x4*)(F.gate + (size_t)bi * DM + k) = a;
    }
    const int gt = idx * (NWAVES * 64) + tid, NGT = nfill * NWAVES * 64;
    for (int e = gt; e < 2 * NB_S * 96 * (NKV / 4); e += NGT) {
        const int which = e / (NB_S * 96 * (NKV / 4)), r = e % (NB_S * 96 * (NKV / 4)), b = r / (96 * (NKV / 4)), q = r % (96 * (NKV / 4));
        const float* src = (which ? F.cache_v : F.cache_k) + ((size_t)b * WIN + 32) * NKV + (size_t)q * 4;
        float* dst = F.out + (which ? OV_S : OK_S) + (size_t)b * WIN * NKV + (size_t)q * 4;
        *(GAS f32x4*)dst = *(const GAS f32x4*)src;
    }
}

__device__ __forceinline__ void p1_weights(Frame& F) {
    LAS float* scr = (LAS float*)(F.lds + RING_OFF + F.wave * 16384);
    const int gw = F.vcu * NWAVES + F.wave, NGW = F.G * NWAVES, lane = F.lane;
    constexpr int I_IN = (DM / 64) * (IN_DIM / 32);
    {
        constexpr int nblk = IN_DIM / 32;
        TrBlk v;
        int it = gw; bool have = it < I_IN;
        if (have) tr_load(F.w_in, IN_DIM, 64 * (it / nblk), colmap(32 * (it % nblk)), lane, v);
        while (have) {
            const int cur = it; it += NGW;
            tr_scatter(v, scr, lane);
            const bool nxt = it < I_IN;
            if (nxt) tr_load(F.w_in, IN_DIM, 64 * (it / nblk), colmap(32 * (it % nblk)), lane, v);
            const int kb = cur / nblk, nb = cur % nblk;
            if (tile_w8(nb >> 3)) transpose_item8(PK_W8, F.W8, 64 * kb, 32 * nb, W8_SCALE, scr, lane);
            if (tile_wb(nb >> 3)) transpose_item(DM, F.Win_t, 64 * kb, 32 * nb, scr, lane);
            have = nxt;
        }
    }
    const int gt = F.vcu * (NWAVES * 64) + F.tid, NGT = F.G * NWAVES * 64;
    for (int e = gt; e < SEQ * 32; e += NGT) {
        const int pos = e >> 5, d = e & 31;
        const double rev = (double)pos * INV_FREQ[d] * 0.15915494309189535;
        const float fr = (float)(rev - __builtin_floor(rev));
        *(GAS float*)(F.ropec + e) = __builtin_amdgcn_cosf(fr); *(GAS float*)(F.ropes + e) = __builtin_amdgcn_sinf(fr);
    }
    for (int e = gt; e < NB_S * HIST * CD / 4; e += NGT) { const f32x4 v = *(const GAS f32x4*)(F.state_conv + (size_t)e * 4); u32x2 w; w.x = cvt_pk_bf16(v[0], v[1]); w.y = cvt_pk_bf16(v[2], v[3]); *(GAS u32x2*)(F.UH + (size_t)e * 4) = w; }
    if (gt < CD / 2) *(GAS unsigned*)(F.ZROW + 2 * gt) = 0u;
}

__device__ __forceinline__ void p1_hrows(Frame& F) {
    LAS float* gs = (LAS float*)(F.lds + RING_OFF); LAS float* sh = gs + DM;
    const int tid = F.tid, lane = F.lane;
    constexpr int NU_P = MP / 64, NU = NU_P + NB_S;
    for (int it = F.vcu; it < NU; it += F.G) {
        const bool samp = it >= NU_P;
        const int bi = samp ? NB_P + (it - NU_P) : (it >> 6);
        const int nrows = samp ? 32 : 64;
        const bool outp = samp || ((it >> 2) & 15) == 15;
        const size_t row0 = samp ? (size_t)MP + (size_t)(it - NU_P) * 32 : (size_t)it * 64;
        const float* x0 = samp ? F.xs + (size_t)(it - NU_P) * 32 * DM : F.xp + (size_t)it * 64 * DM;
        __syncthreads();
        { const int k = 4 * tid;
          f32x4 s0 = *(const GAS f32x4*)(F.b_ada + k), s1 = *(const GAS f32x4*)(F.b_ada + DM + k);
#pragma unroll
          for (int ks = 0; ks < KS_ADA; ++ks) { const float* p = F.part + ((size_t)ks * NMOD + bi) * MOD_N + k; s0 += *(const GAS f32x4*)p; s1 += *(const GAS f32x4*)(p + DM); }
          const f32x4 g = *(const GAS f32x4*)(F.norm_g + k);
          *(LAS f32x4*)(sh + k) = s0; *(LAS f32x4*)(gs + k) = g * (s1 + 1.0f); }
        __syncthreads();
        for (int r = F.wave; r < nrows; r += 2 * NWAVES) {
            const GAS f32x4* xr = (const GAS f32x4*)(x0 + (size_t)r * DM) + 2 * lane;
            f32x4 v[2][8]; float s[2] = {0.f, 0.f};
#pragma unroll
            for (int h = 0; h < 2; ++h)
#pragma unroll
                for (int j = 0; j < 4; ++j) { v[h][2 * j] = xr[h * NWAVES * (DM / 4) + 128 * j]; v[h][2 * j + 1] = xr[h * NWAVES * (DM / 4) + 128 * j + 1]; }
#pragma unroll
            for (int h = 0; h < 2; ++h)
#pragma unroll
                for (int j = 0; j < 8; ++j) s[h] += (v[h][j][0] * v[h][j][0] + v[h][j][1] * v[h][j][1]) + (v[h][j][2] * v[h][j][2] + v[h][j][3] * v[h][j][3]);
#pragma unroll
            for (int h = 0; h < 2; ++h) {
                const float rstd = 1.0f / sqrtf(wave_sum(s[h]) * (1.0f / DM) + RMS_EPS);
                const size_t rowg = row0 + r + h * NWAVES; const bool gat = !samp && (rowg & (SEQ - 1)) >= SEQ - 32;
                GAS u32x4* og = (GAS u32x4*)(F.HG + ((rowg >> 12) * 32 + (rowg & 31)) * DM) + lane;
                GAS u32x4* o = (GAS u32x4*)(F.H + (row0 + r + h * NWAVES) * DM) + lane; GAS u32x2* o8 = (GAS u32x2*)(F.H8 + (row0 + r + h * NWAVES) * PK_H8) + lane;
#pragma unroll
                for (int j = 0; j < 4; ++j) {
                    const f32x4 g0 = *(const LAS f32x4*)(gs + 8 * lane + 512 * j), g1 = *(const LAS f32x4*)(gs + 8 * lane + 512 * j + 4), s0 = *(const LAS f32x4*)(sh + 8 * lane + 512 * j), s1 = *(const LAS f32x4*)(sh + 8 * lane + 512 * j + 4);
                    const f32x4 h0 = v[h][2 * j] * rstd * g0 + s0, h1 = v[h][2 * j + 1] * rstd * g1 + s1;
                    if (outp) { const u32x4 hb = pack8(h0, h1); o[64 * j] = hb; if (gat) og[64 * j] = hb; }
                    o8[64 * j] = pack8_fp8(h0, h1);
                }
            }
        }
    }
    __syncthreads();
}

constexpr int KS_OFF = 0, KS_STRIDE = 144, VT_OFF = 28672, VT_STRIDE = 392;
__device__ __forceinline__ void attn_unit(Frame& F, int unit) {
    const int tid = F.tid, lane = F.lane, wave = F.wave;
    const bool samp = unit >= NB_P * 64 * 4;
    int b, j, kvh;
    if (!samp) { kvh = unit & 3; j = (unit >> 2) & 63; b = unit >> 8; } else { const int u2 = unit - NB_P * 64 * 4; kvh = u2 & 3; b = u2 >> 2; j = 0; }
    const int j0 = j > 2 ? j - 2 : 0, nk = j - j0 + 1, ntile = samp ? 5 : 2 * nk;
    LAS unsigned char* lds = F.lds;
#pragma unroll
    for (int i = 0; i < 3; ++i) {
        const int idx = tid + 512 * i; const int key = idx >> 3, ch = idx & 7;
        if (idx < (samp ? 1280 : nk * 512)) {
            u32x4 kv, vv;
            if (samp && key < WIN) {
                const size_t co = (((size_t)b * WIN + key) * 4 + kvh) * 64 + ch * 8;
                kv = pack8(*(const GAS f32x4*)(F.cache_k + co), *(const GAS f32x4*)(F.cache_k + co + 4));
                vv = pack8(*(const GAS f32x4*)(F.cache_v + co), *(const GAS f32x4*)(F.cache_v + co + 4));
            } else {
                const size_t row = samp ? (size_t)MP + b * SEQ_S + (key - WIN) : (size_t)b * SEQ + j0 * 64 + key;
                kv = *(const GAS u32x4*)(F.Kb + row * NKV + kvh * 64 + ch * 8); vv = *(const GAS u32x4*)(F.Vb + row * NKV + kvh * 64 + ch * 8);
            }
            *(LAS u32x4*)(lds + KS_OFF + key * KS_STRIDE + ch * 16) = kv;
            LAS unsigned short* vt = (LAS unsigned short*)(lds + VT_OFF + (ch * 8) * VT_STRIDE) + key;
            vt[0 * (VT_STRIDE / 2)] = (unsigned short)(vv.x & 0xffffu); vt[1 * (VT_STRIDE / 2)] = (unsigned short)(vv.x >> 16);
            vt[2 * (VT_STRIDE / 2)] = (unsigned short)(vv.y & 0xffffu); vt[3 * (VT_STRIDE / 2)] = (unsigned short)(vv.y >> 16);
            vt[4 * (VT_STRIDE / 2)] = (unsigned short)(vv.z & 0xffffu); vt[5 * (VT_STRIDE / 2)] = (unsigned short)(vv.z >> 16);
            vt[6 * (VT_STRIDE / 2)] = (unsigned short)(vv.w & 0xffffu); vt[7 * (VT_STRIDE / 2)] = (unsigned short)(vv.w >> 16);
        }
    }
    __syncthreads();
    if (!samp || wave < 4) {
        const int g = samp ? wave : (wave >> 1), tok0 = samp ? 0 : 32 * (wave & 1);
        const int head = kvh * 4 + g, q = lane & 31, hi = lane >> 5;
        const size_t qrow = (samp ? (size_t)MP + b * SEQ_S : (size_t)b * SEQ + j * 64) + tok0 + q;
        bf16x8 qf[4];
#pragma unroll
        for (int ds = 0; ds < 4; ++ds) qf[ds] = *(const GAS bf16x8*)(F.Qb + qrow * NQ + head * 64 + 16 * ds + 8 * hi);
        const float sinkl = *(const GAS float*)(F.sinks + head) * LOG2E;
        f32x16 st[6];
#pragma unroll
        for (int t = 0; t < 6; ++t) {
#pragma unroll
            for (int r = 0; r < 16; ++r) st[t][r] = 0.f;
            if (t < ntile) {
#pragma unroll
                for (int ds = 0; ds < 4; ++ds) { const bf16x8 kf = *(const LAS bf16x8*)(lds + KS_OFF + (32 * t + q) * KS_STRIDE + (16 * ds + 8 * hi) * 2);
                    st[t] = __builtin_amdgcn_mfma_f32_32x32x16_bf16(kf, qf[ds], st[t], 0, 0, 0); }
            }
        }
        float mx = sinkl;
#pragma unroll
        for (int t = 0; t < 6; ++t) if (t < ntile) {
#pragma unroll
            for (int r = 0; r < 16; ++r) mx = fmaxf(mx, st[t][r]); }
        mx = fmaxf(mx, __shfl_xor(mx, 32));
        float l = 0.f;
#pragma unroll
        for (int t = 0; t < 6; ++t) if (t < ntile) {
#pragma unroll
            for (int r = 0; r < 16; ++r) { const float p = __builtin_amdgcn_exp2f(st[t][r] - mx); st[t][r] = p; l += p; } }
        l += __shfl_xor(l, 32); l += __builtin_amdgcn_exp2f(sinkl - mx);
        const float rl = 1.0f / l;
        f32x16 ot[2];
#pragma unroll
        for (int d0 = 0; d0 < 2; ++d0)
#pragma unroll
            for (int r = 0; r < 16; ++r) ot[d0][r] = 0.f;
#pragma unroll
        for (int t = 0; t < 6; ++t) if (t < ntile) {
#pragma unroll
            for (int s = 0; s < 2; ++s) {
                u32x4 pw; pw.x = cvt_pk_bf16(st[t][8 * s], st[t][8 * s + 1]); pw.y = cvt_pk_bf16(st[t][8 * s + 2], st[t][8 * s + 3]); pw.z = cvt_pk_bf16(st[t][8 * s + 4], st[t][8 * s + 5]); pw.w = cvt_pk_bf16(st[t][8 * s + 6], st[t][8 * s + 7]);
                const bf16x8 pb = __builtin_bit_cast(bf16x8, pw);
#pragma unroll
                for (int d0 = 0; d0 < 2; ++d0) {
                    const LAS unsigned char* vp = lds + VT_OFF + (32 * d0 + q) * VT_STRIDE + (32 * t + 16 * s + 4 * hi) * 2;
                    const s16x4 lo = *(const LAS s16x4*)vp, h4 = *(const LAS s16x4*)(vp + 16);
                    const bf16x8 vf = (bf16x8){lo[0], lo[1], lo[2], lo[3], h4[0], h4[1], h4[2], h4[3]};
                    ot[d0] = __builtin_amdgcn_mfma_f32_32x32x16_bf16(vf, pb, ot[d0], 0, 0, 0);
                }
            }
        }
#pragma unroll
        for (int d0 = 0; d0 < 2; ++d0)
#pragma unroll
            for (int rq = 0; rq < 4; ++rq) {
                const size_t off = qrow * NQ + head * 64 + 32 * d0 + 8 * rq + 4 * hi;
                const u32x2 g2 = *(const GAS u32x2*)(F.SGA + off);
                const float rs = rl * A8_SCALE;
                int w = cvt2_fp8(ot[d0][4 * rq] * rs * bf_lo(g2.x), ot[d0][4 * rq + 1] * rs * bf_hi(g2.x), 0, false);
                w = cvt2_fp8(ot[d0][4 * rq + 2] * rs * bf_lo(g2.y), ot[d0][4 * rq + 3] * rs * bf_hi(g2.y), w, true);
                *(GAS unsigned*)((GAS unsigned char*)F.A1 + off + qrow * (PK_A12 - NQ)) = (unsigned)w;
            }
    }
    __syncthreads();
}

constexpr int AB_K0 = 0, AB_V0 = 27648, AB_IMG = 53760, AB_OST = 107520, OST_STRIDE = 144;
static_assert(AB_OST + 8 * 32 * OST_STRIDE <= LDSCTL_OFF, "attention LDS map");
__device__ __forceinline__ void attn_prompt_loop(Frame& F) {
    constexpr int NP = NB_P * 64 * 4;
    const int tid = F.tid, lane = F.lane, wave = F.wave;
    const int q = lane & 31, hi = lane >> 5, g = wave >> 1, tok0 = 32 * (wave & 1);
    const int rr8 = lane >> 3, c8 = lane & 7;
    LAS unsigned char* ost = F.lds + AB_OST + wave * (32 * OST_STRIDE);
    u32x4 kreg[3], vreg[3], qn[4];
#define AT_ISSUE(un_) do { const int b_ = (un_) >> 8, j_ = ((un_) >> 2) & 63, kvh_ = (un_) & 3, j0_ = j_ > 2 ? j_ - 2 : 0, nk_ = j_ - j0_ + 1; \
        _Pragma("unroll") for (int i_ = 0; i_ < 3; ++i_) { const int idx_ = tid + 512 * i_; if (idx_ < nk_ * 512) { const size_t ro_ = ((size_t)b_ * SEQ + j0_ * 64 + (idx_ >> 3)) * NKV + kvh_ * 64 + (idx_ & 7) * 8; \
            kreg[i_] = *(const GAS u32x4*)(F.Kb + ro_); vreg[i_] = *(const GAS u32x4*)(F.Vb + ro_); } } \
        const size_t qo_ = ((size_t)b_ * SEQ + j_ * 64 + tok0 + rr8) * NQ + (kvh_ * 4 + g) * 64 + 8 * c8; \
        _Pragma("unroll") for (int i_ = 0; i_ < 4; ++i_) qn[i_] = *(const GAS u32x4*)(F.Qb + qo_ + (size_t)(8 * i_) * NQ); } while (0)
    int un = F.vcu, par = 0;
    if (un < NP) AT_ISSUE(un);
    for (; un < NP; un += F.G, par ^= 1) {
        const int b = un >> 8, j = (un >> 2) & 63, kvh = un & 3, j0 = j > 2 ? j - 2 : 0, nk = j - j0 + 1, ntile = 2 * nk;
        LAS unsigned char* lds = F.lds + par * AB_IMG;
#pragma unroll
        for (int i = 0; i < 3; ++i) {
            const int idx = tid + 512 * i; const int key = idx >> 3, ch = idx & 7;
            if (idx < nk * 512) {
                const u32x4 kv = kreg[i], vv = vreg[i];
                *(LAS u32x4*)(lds + AB_K0 + key * KS_STRIDE + ch * 16) = kv;
                LAS unsigned short* vt = (LAS unsigned short*)(lds + AB_V0 + (ch * 8) * VT_STRIDE) + key;
                vt[0 * (VT_STRIDE / 2)] = (unsigned short)(vv.x & 0xffffu); vt[1 * (VT_STRIDE / 2)] = (unsigned short)(vv.x >> 16);
                vt[2 * (VT_STRIDE / 2)] = (unsigned short)(vv.y & 0xffffu); vt[3 * (VT_STRIDE / 2)] = (unsigned short)(vv.y >> 16);
                vt[4 * (VT_STRIDE / 2)] = (unsigned short)(vv.z & 0xffffu); vt[5 * (VT_STRIDE / 2)] = (unsigned short)(vv.z >> 16);
                vt[6 * (VT_STRIDE / 2)] = (unsigned short)(vv.w & 0xffffu); vt[7 * (VT_STRIDE / 2)] = (unsigned short)(vv.w >> 16);
            }
        }
#pragma unroll
        for (int i = 0; i < 4; ++i) *(LAS u32x4*)(ost + (rr8 + 8 * i) * OST_STRIDE + c8 * 16) = qn[i];
        __syncthreads();
        bf16x8 qf[4];
#pragma unroll
        for (int ds = 0; ds < 4; ++ds) qf[ds] = *(const LAS bf16x8*)(ost + q * OST_STRIDE + (16 * ds + 8 * hi) * 2);
        if (un + F.G < NP) AT_ISSUE(un + F.G);
        const int head = kvh * 4 + g;
        const size_t orow = ((size_t)b * SEQ + j * 64 + tok0 + rr8) * NQ + head * 64 + 8 * c8;
        const size_t orow8 = ((size_t)b * SEQ + j * 64 + tok0 + rr8) * PK_A12 + head * 64 + 8 * c8;
        u32x4 sg[4];
#pragma unroll
        for (int i = 0; i < 4; ++i) sg[i] = *(const GAS u32x4*)(F.SGA + orow + (size_t)(8 * i) * NQ);
        const float sinkl = *(const GAS float*)(F.sinks + head) * LOG2E;
        f32x16 st[6], zacc;
#pragma unroll
        for (int r = 0; r < 16; ++r) zacc[r] = 0.f;
#pragma unroll
        for (int t = 0; t < 6; ++t) {
            st[t] = zacc;
            if (t < ntile) {
#pragma unroll
                for (int ds = 0; ds < 4; ++ds) { const bf16x8 kf = *(const LAS bf16x8*)(lds + AB_K0 + (32 * t + q) * KS_STRIDE + (16 * ds + 8 * hi) * 2);
                    st[t] = __builtin_amdgcn_mfma_f32_32x32x16_bf16(kf, qf[ds], ds == 0 ? zacc : st[t], 0, 0, 0); }
            }
        }
        float mx = sinkl;
#pragma unroll
        for (int t = 0; t < 6; ++t) if (t < ntile) {
            float m0 = fmaxf(fmaxf(st[t][0], st[t][1]), st[t][2]), m1 = fmaxf(fmaxf(st[t][3], st[t][4]), st[t][5]), m2 = fmaxf(fmaxf(st[t][6], st[t][7]), st[t][8]), m3 = fmaxf(fmaxf(st[t][9], st[t][10]), st[t][11]);
            m0 = fmaxf(fmaxf(m0, st[t][12]), st[t][13]); m1 = fmaxf(fmaxf(m1, st[t][14]), st[t][15]); m2 = fmaxf(fmaxf(m2, m3), mx); mx = fmaxf(fmaxf(m0, m1), m2); }
        mx = fmaxf(mx, __shfl_xor(mx, 32));
        float l = 0.f;
#pragma unroll
        for (int t = 0; t < 6; ++t) if (t < ntile) {
#pragma unroll
            for (int r = 0; r < 16; ++r) { const float p = __builtin_amdgcn_exp2f(st[t][r] - mx); st[t][r] = p; l += p; } }
        l += __shfl_xor(l, 32); l += __builtin_amdgcn_exp2f(sinkl - mx);
        const float rl = 1.0f / l;
        f32x16 ot[2]; ot[0] = zacc; ot[1] = zacc;
#pragma unroll
        for (int t = 0; t < 6; ++t) if (t < ntile) {
#pragma unroll
            for (int s = 0; s < 2; ++s) {
                u32x4 pw; pw.x = cvt_pk_bf16(st[t][8 * s], st[t][8 * s + 1]); pw.y = cvt_pk_bf16(st[t][8 * s + 2], st[t][8 * s + 3]); pw.z = cvt_pk_bf16(st[t][8 * s + 4], st[t][8 * s + 5]); pw.w = cvt_pk_bf16(st[t][8 * s + 6], st[t][8 * s + 7]);
                const bf16x8 pb = __builtin_bit_cast(bf16x8, pw);
#pragma unroll
                for (int d0 = 0; d0 < 2; ++d0) {
                    const LAS unsigned char* vp = lds + AB_V0 + (32 * d0 + q) * VT_STRIDE + (32 * t + 16 * s + 4 * hi) * 2;
                    const s16x4 lo = *(const LAS s16x4*)vp, h4 = *(const LAS s16x4*)(vp + 16);
                    const bf16x8 vf = (bf16x8){lo[0], lo[1], lo[2], lo[3], h4[0], h4[1], h4[2], h4[3]};
                    ot[d0] = __builtin_amdgcn_mfma_f32_32x32x16_bf16(vf, pb, ot[d0], 0, 0, 0);
                }
            }
        }
#pragma unroll
        for (int d0 = 0; d0 < 2; ++d0)
#pragma unroll
            for (int rq = 0; rq < 4; ++rq) {
                u32x2 w; w.x = cvt_pk_bf16(ot[d0][4 * rq] * rl, ot[d0][4 * rq + 1] * rl); w.y = cvt_pk_bf16(ot[d0][4 * rq + 2] * rl, ot[d0][4 * rq + 3] * rl);
                *(LAS u32x2*)(ost + q * OST_STRIDE + (32 * d0 + 8 * rq + 4 * hi) * 2) = w;
            }
        LDS_WAIT();
#pragma unroll
        for (int i = 0; i < 4; ++i) {
            const u32x4 o4 = *(const LAS u32x4*)(ost + (rr8 + 8 * i) * OST_STRIDE + c8 * 16), g4 = sg[i];
            const f32x4 p0 = (f32x4){bf_lo(o4.x) * bf_lo(g4.x), bf_hi(o4.x) * bf_hi(g4.x), bf_lo(o4.y) * bf_lo(g4.y), bf_hi(o4.y) * bf_hi(g4.y)} * A8_SCALE;
            const f32x4 p1 = (f32x4){bf_lo(o4.z) * bf_lo(g4.z), bf_hi(o4.z) * bf_hi(g4.z), bf_lo(o4.w) * bf_lo(g4.w), bf_hi(o4.w) * bf_hi(g4.w)} * A8_SCALE;
            *(GAS u32x2*)((GAS unsigned char*)F.A1 + orow8 + (size_t)(8 * i) * PK_A12) = pack8_fp8(p0, p1);
        }
        LDS_WAIT();
    }
#undef AT_ISSUE
    __syncthreads();
}

template <int I> __device__ __forceinline__ void conv_row(f32x2 (&y)[32], const f32x2 (&w)[CW], const unsigned (&pk)[32 + HIST]) {
    if constexpr (I < 32 + HIST) {
        const f32x2 u = (f32x2){bf_lo(pk[I]), bf_hi(pk[I])};
        constexpr int lo = I - (CW - 1) > 0 ? I - (CW - 1) : 0, hi = I < 31 ? I : 31;
#pragma unroll
        for (int o = lo; o <= hi; ++o) y[o] = __builtin_elementwise_fma(w[I - o], u, y[o]);
        conv_row<I + 1>(y, w, pk);
    }
}
__device__ __forceinline__ void conv_phase(Frame& F, int first, int stride) {
    const int tid = F.tid, lane = F.lane, wave = F.wave;
    LAS float* red = (LAS float*)(F.lds + 65536);
    LAS float* stats = red + 8 * 64;
    f32x2 wv[CW];
#pragma unroll
    for (int w = 0; w < CW; ++w) wv[w] = *(const GAS f32x2*)(F.w_dw + w * CD + 2 * tid);
    const f32x2 bdw = *(const GAS f32x2*)(F.b_dw + 2 * tid), lg = *(const GAS f32x2*)(F.ln_g + 2 * tid), lb = *(const GAS f32x2*)(F.ln_b + 2 * tid);
    constexpr int NU_P = MP / 32, NU = NU_P + NB_S, NR = 32 + HIST;
    for (int unit = first; unit < NU; unit += stride) {
        const bool samp = unit >= NU_P;
        const int b = samp ? unit - NU_P : unit >> 7, t0 = samp ? 0 : (unit & 127) * 32;
        const size_t rowbase = samp ? (size_t)MP + b * SEQ_S : (size_t)b * SEQ;
        unsigned pk[NR];
        if (t0 != 0) {
            const GAS bf16_t* rp = (const GAS bf16_t*)F.U + (rowbase + t0 - HIST) * CD + 2 * tid;
#pragma unroll
            for (int i = 0; i < NR; ++i) { pk[i] = *(const GAS unsigned*)rp; rp += CD; asm volatile("" : "+v"(rp)); }
        } else {
            const GAS bf16_t* hp = (const GAS bf16_t*)(samp ? F.UH + (size_t)b * HIST * CD : F.ZROW) + 2 * tid; const int hstride = samp ? CD : 0;
#pragma unroll
            for (int i = 0; i < HIST; ++i) { pk[i] = *(const GAS unsigned*)hp; hp += hstride; asm volatile("" : "+v"(hp)); }
            const GAS bf16_t* rp = (const GAS bf16_t*)F.U + rowbase * CD + 2 * tid;
#pragma unroll
            for (int i = HIST; i < NR; ++i) { pk[i] = *(const GAS unsigned*)rp; rp += CD; asm volatile("" : "+v"(rp)); }
        }
        f32x2 yv[32];
#pragma unroll
        for (int o = 0; o < 32; ++o) yv[o] = bdw;
        conv_row<0>(yv, wv, pk);
        unsigned gb[32];
        const GAS bf16_t* gp = (const GAS bf16_t*)F.SGB + (rowbase + t0) * CD + 2 * tid;
#pragma unroll
        for (int o = 0; o < 32; ++o) { gb[o] = *(const GAS unsigned*)gp; gp += CD; asm volatile("" : "+v"(gp)); }
        float a5[32], a4[16], a3[8], a2[4], a1[2], a0;
        { const bool up = (lane & 32) != 0;
#pragma unroll
          for (int j = 0; j < 32; ++j) { const float s1 = yv[j][0] + yv[j][1], s2 = yv[j][0] * yv[j][0] + yv[j][1] * yv[j][1]; const float keep = up ? s2 : s1, send = up ? s1 : s2; a5[j] = keep + __shfl_xor(send, 32); } }
        { const bool up = (lane & 16) != 0;
#pragma unroll
          for (int j = 0; j < 16; ++j) { const float keep = up ? a5[16 + j] : a5[j], send = up ? a5[j] : a5[16 + j]; a4[j] = keep + __shfl_xor(send, 16); } }
        { const bool up = (lane & 8) != 0;
#pragma unroll
          for (int j = 0; j < 8; ++j) { const float keep = up ? a4[8 + j] : a4[j], send = up ? a4[j] : a4[8 + j]; a3[j] = keep + __shfl_xor(send, 8); } }
        { const bool up = (lane & 4) != 0;
#pragma unroll
          for (int j = 0; j < 4; ++j) { const float keep = up ? a3[4 + j] : a3[j], send = up ? a3[j] : a3[4 + j]; a2[j] = keep + __shfl_xor(send, 4); } }
        { const bool up = (lane & 2) != 0;
#pragma unroll
          for (int j = 0; j < 2; ++j) { const float keep = up ? a2[2 + j] : a2[j], send = up ? a2[j] : a2[2 + j]; a1[j] = keep + __shfl_xor(send, 2); } }
        { const bool up = (lane & 1) != 0; const float keep = up ? a1[1] : a1[0], send = up ? a1[0] : a1[1]; a0 = keep + __shfl_xor(send, 1); }
        red[wave * 64 + lane] = a0;
        __syncthreads();
        if (tid < 32) {
            float S1 = 0.f, S2 = 0.f;
#pragma unroll
            for (int wv = 0; wv < NWAVES; ++wv) { S1 += red[wv * 64 + tid]; S2 += red[wv * 64 + 32 + tid]; }
            const float mean = S1 * (1.0f / CD), var = fmaxf(S2 * (1.0f / CD) - mean * mean, 0.f);
            *(LAS f32x2*)(stats + 2 * tid) = (f32x2){mean, 1.0f / sqrtf(var + LN_EPS)};
        }
        __syncthreads();
        GAS unsigned char* op = (GAS unsigned char*)F.A2 + (rowbase + t0) * PK_A12 + 2 * tid;
#pragma unroll
        for (int o = 0; o < 32; ++o) {
            const f32x2 st = *(const LAS f32x2*)(stats + 2 * o);
            const float n0 = (yv[o][0] - st[0]) * st[1] * lg[0] + lb[0], n1 = (yv[o][1] - st[0]) * st[1] * lg[1] + lb[1];
            *(GAS unsigned short*)op = (unsigned short)cvt2_fp8(n0 * fast_sigmoid(n0) * bf_lo(gb[o]) * A8_SCALE, n1 * fast_sigmoid(n1) * bf_hi(gb[o]) * A8_SCALE, 0, false); op += PK_A12; asm volatile("" : "+v"(op));
        }
    }
    __syncthreads();
}

__device__ __forceinline__ void side_outputs(Frame& F) {
    const int gt = F.vcu * (NWAVES * 64) + F.tid, NGT = F.G * NWAVES * 64;
    constexpr int G_KP = NB_P * WIN * NKV / 8, G_KS = NB_S * SEQ_S * NKV / 8, G_CP = NB_P * HIST * CD / 8, G_CS = NB_S * HIST * CD / 8;
    for (int e = gt; e < 2 * G_KP + 2 * G_KS + G_CP + G_CS; e += NGT) {
        int r = e; const bf16_t* src; float* dst;
        if (r < 2 * G_KP) { const int which = r / G_KP; r %= G_KP; const int b = r / (WIN * NKV / 8), rem = r % (WIN * NKV / 8), i = rem / (NKV / 8), c8 = rem % (NKV / 8);
            src = (which ? F.Vb : F.Kb) + ((size_t)b * SEQ + SEQ - WIN + i) * NKV + c8 * 8; dst = F.out + (which ? OV_P : OK_P) + ((size_t)b * WIN + i) * NKV + c8 * 8; }
        else if (r < 2 * G_KP + 2 * G_KS) { r -= 2 * G_KP; const int which = r / G_KS; r %= G_KS; const int b = r / (SEQ_S * NKV / 8), rem = r % (SEQ_S * NKV / 8), t = rem / (NKV / 8), c8 = rem % (NKV / 8);
            src = (which ? F.Vb : F.Kb) + ((size_t)MP + b * SEQ_S + t) * NKV + c8 * 8; dst = F.out + (which ? OV_S : OK_S) + ((size_t)b * WIN + (WIN - SEQ_S) + t) * NKV + c8 * 8; }
        else if (r < 2 * G_KP + 2 * G_KS + G_CP) { r -= 2 * G_KP + 2 * G_KS; const int b = r / (HIST * CD / 8), rem = r % (HIST * CD / 8), i = rem / (CD / 8), c8 = rem % (CD / 8);
            src = F.UX + ((size_t)b * 32 + (32 - HIST) + i) * CD + c8 * 8; dst = F.out + OC_P + ((size_t)b * HIST + i) * CD + c8 * 8; }
        else { r -= 2 * G_KP + 2 * G_KS + G_CP; const int b = r / (HIST * CD / 8), rem = r % (HIST * CD / 8), i = rem / (CD / 8), c8 = rem % (CD / 8);
            src = F.U + ((size_t)MP + b * SEQ_S + (SEQ_S - HIST) + i) * CD + c8 * 8; dst = F.out + OC_S + ((size_t)b * HIST + i) * CD + c8 * 8; }
        const u32x4 v = *(const GAS u32x4*)src;
        *(GAS f32x4*)dst = (f32x4){bf_lo(v.x), bf_hi(v.x), bf_lo(v.y), bf_hi(v.y)}; *(GAS f32x4*)(dst + 4) = (f32x4){bf_lo(v.z), bf_hi(v.z), bf_lo(v.w), bf_hi(v.w)};
    }
}

__device__ __forceinline__ void p6_final(Frame& F, const bf16_t* ybr) {
    const int gw = F.vcu * NWAVES + F.wave, NGW = F.G * NWAVES, lane = F.lane;
    f32x4 fg[4][2];
#pragma unroll
    for (int j = 0; j < 4; ++j) { fg[j][0] = *(const GAS f32x4*)(F.final_g + 8 * lane + 512 * j); fg[j][1] = *(const GAS f32x4*)(F.final_g + 8 * lane + 512 * j + 4); }
    u32x4 b[2][4]; f32x4 x[2][8];
#define P6_ISSUE(r_, buf_) do { const int rc_ = (r_) < M ? (r_) : M - 1; const GAS u32x4* br_ = (const GAS u32x4*)(ybr + (size_t)rc_ * DM) + lane; \
        const GAS f32x4* xr_ = (const GAS f32x4*)(rc_ < MP ? F.xp + (size_t)rc_ * DM : F.xs + (size_t)(rc_ - MP) * DM) + 2 * lane; \
        _Pragma("unroll") for (int j_ = 0; j_ < 4; ++j_) { b[buf_][j_] = br_[64 * j_]; x[buf_][2 * j_] = xr_[128 * j_]; x[buf_][2 * j_ + 1] = xr_[128 * j_ + 1]; } } while (0)
#define P6_ROW(r_, buf_) do { float ss_ = 0.f; \
        _Pragma("unroll") for (int j_ = 0; j_ < 4; ++j_) { const u32x4 w_ = b[buf_][j_]; \
            x[buf_][2 * j_] += (f32x4){bf_lo(w_.x), bf_hi(w_.x), bf_lo(w_.y), bf_hi(w_.y)}; x[buf_][2 * j_ + 1] += (f32x4){bf_lo(w_.z), bf_hi(w_.z), bf_lo(w_.w), bf_hi(w_.w)}; \
            const f32x4 a_ = x[buf_][2 * j_], c_ = x[buf_][2 * j_ + 1]; \
            ss_ += ((a_[0] * a_[0] + a_[1] * a_[1]) + (a_[2] * a_[2] + a_[3] * a_[3])) + ((c_[0] * c_[0] + c_[1] * c_[1]) + (c_[2] * c_[2] + c_[3] * c_[3])); } \
        const float rstd_ = 1.0f / sqrtf(wave_sum(ss_) * (1.0f / DM) + RMS_EPS); \
        GAS f32x4* o_ = (GAS f32x4*)(F.out + (size_t)(r_) * DM) + 2 * lane; \
        _Pragma("unroll") for (int j_ = 0; j_ < 4; ++j_) { o_[128 * j_] = x[buf_][2 * j_] * rstd_ * fg[j_][0]; o_[128 * j_ + 1] = x[buf_][2 * j_ + 1] * rstd_ * fg[j_][1]; } } while (0)
    int row = gw;
    if (row < M) P6_ISSUE(row, 0);
    for (; row < M; row += 2 * NGW) {
        P6_ISSUE(row + NGW, 1);
        P6_ROW(row, 0);
        if (row + NGW < M) { P6_ISSUE(row + 2 * NGW, 0); P6_ROW(row + NGW, 1); }
    }
#undef P6_ISSUE
#undef P6_ROW
}

constexpr int N_PHASES = 7;
constexpr int WGM1 = 4, WGM2 = 2, WGM3 = 2;
constexpr int REP[7] = {1, 1, 1, 1, 1, 1, 1};
#ifndef MK_N_LAUNCHES
#define MK_N_LAUNCHES 1
#endif
struct Args { const float* in[20]; float* out; unsigned char* ws; int ph_lo, ph_hi; };
__global__ void __launch_bounds__(NWAVES * 64, 2) skel_fwd(Args args) {
    extern __shared__ __attribute__((aligned(16))) unsigned char lds_raw[];
    Frame F;
    F.lds = (LAS unsigned char*)lds_raw;
    F.tid = threadIdx.x; F.lane = F.tid & 63; F.wave = __builtin_amdgcn_readfirstlane(F.tid >> 6);
    F.G = gridDim.x; { const int bx = blockIdx.x; F.vcu = (F.G % 8 == 0) ? (bx % 8) * (F.G / 8) + bx / 8 : bx; }
    unsigned char* ws = args.ws;
    F.xp = args.in[0]; F.xs = args.in[1]; F.cp = args.in[2]; F.cs = args.in[3]; F.cache_k = args.in[4]; F.cache_v = args.in[5]; F.state_conv = args.in[6];
    F.norm_g = args.in[7]; F.w_ada = args.in[8]; F.b_ada = args.in[9]; F.w_in = args.in[10]; F.sinks = args.in[11]; F.w_dw = args.in[12]; F.b_dw = args.in[13];
    F.ln_g = args.in[14]; F.ln_b = args.in[15]; F.w_pa = args.in[16]; F.w_pb = args.in[17]; F.w_out = args.in[18]; F.final_g = args.in[19];
    F.out = args.out;
    F.gate = (float*)(ws + WS_GATE); F.ropec = (float*)(ws + WS_ROPE_C); F.ropes = (float*)(ws + WS_ROPE_S); F.rss = (float*)(ws + WS_RSS); F.part = (float*)(ws + WS_PART);
    F.Win_t = (bf16_t*)(ws + WS_WIN); F.Wa_t = (bf16_t*)(ws + WS_WA); F.Wb_t = (bf16_t*)(ws + WS_WB); F.Wo_t = (bf16_t*)(ws + WS_WO);
    F.W8 = ws + WS_W8; F.H8 = ws + WS_H8;
    F.H = (bf16_t*)(ws + WS_H); F.Qb = (bf16_t*)(ws + WS_Q); F.Kb = (bf16_t*)(ws + WS_K); F.Vb = (bf16_t*)(ws + WS_V);
    F.SGA = (bf16_t*)(ws + WS_SGA); F.U = (bf16_t*)(ws + WS_U); F.SGB = (bf16_t*)(ws + WS_SGB); F.SMG = (bf16_t*)(ws + WS_SMG); F.A1 = (bf16_t*)(ws + WS_A1); F.A2 = (bf16_t*)(ws + WS_A2); F.UH = (bf16_t*)(ws + WS_UH); F.UX = (bf16_t*)(ws + WS_UX); F.HG = (bf16_t*)(ws + WS_HG); F.ZROW = (bf16_t*)(ws + WS_ZROW);
    for (int u = F.tid; u < (LDS_BYTES - LDSCTL_OFF) / 4; u += NWAVES * 64) ((LAS unsigned*)(F.lds + LDSCTL_OFF))[u] = 0u;
    __syncthreads();
    unsigned* ctl = (unsigned*)(ws + WS_CTL);
    XcdBarrier bar; bar.bar = ctl + CW_BAR; bar.x = 0; bar.st = nullptr;
    const int lo = args.ph_lo, hi = args.ph_hi;
    if (hi - lo > 1) bar = xcd_barrier_post(ctl + CW_BAR, (volatile LAS unsigned*)(F.lds + MISC_OFF) + 8);
#define IN(k) (lo <= (k) && (k) < hi)
#define SEAM(k) do { if (IN(k) && IN((k) + 1)) xcd_barrier(bar); } while (0)

#define ARRIVE(k) do { if (IN(k) && IN((k) + 1)) xcd_barrier_arrive(bar); } while (0)
#define WAIT(k) do { if (IN(k) && IN((k) + 1)) xcd_barrier_wait(bar); } while (0)
    if (IN(0)) { p0_prologue(F); ARRIVE(0); p1_weights(F); WAIT(0); }
    if (IN(1)) { p1_hrows(F); ARRIVE(1); p2_fill(F, (int)blockIdx.x, F.G, 0); WAIT(1); }
    if (IN(2)) {
        constexpr int NU_B = 64;
        const int nb = F.G >= 2 * NU_B ? NU_B : 0;
        { pg8::Gemm g{F.H, F.HG, F.Win_t, F.Win_t, DM}; pg8::Order S; S.init_inproj(3, F.G, (int)blockIdx.x, F.vcu, WGM1, 0);
          Epi1<false> E{F.Qb, F.Kb, F.Vb, F.SGA, F.U, F.SGB, F.SMG, F.ropec, F.ropes, F.UX};
          for (int rep = 0; rep < REP[2]; ++rep) pg8::gemm_phase<Epi1<false>, true, true, false>(F.lds + RING_OFF, g, S, E); }
        { pg8::Gemm g{F.H8, F.H8, F.W8, F.W8, DM, PK_H8, PK_W8}; pg8::Order S; S.init_inproj(4, F.G, (int)blockIdx.x, F.vcu, WGM1, nb);
          Epi1<true> E{F.Qb, F.Kb, F.Vb, F.SGA, F.U, F.SGB, F.SMG, F.ropec, F.ropes, F.UX};
          for (int rep = 0; rep < REP[2]; ++rep) pg8::gemm_phase<Epi1<true>, true, true, true>(F.lds + RING_OFF, g, S, E); }
        ARRIVE(2);
        p2_fill(F, (int)blockIdx.x, F.G, 1);
        WAIT(2);
    }
    if (IN(3)) {
        constexpr int NATT = NB_P * 64 * 4 + NB_S * 4;
        for (int rep = 0; rep < REP[3]; ++rep) {
        attn_prompt_loop(F);
        for (int it = F.vcu; it < NATT; it += F.G) if (it >= NB_P * 64 * 4) attn_unit(F, it);
        conv_phase(F, F.G - 1 - F.vcu, F.G);
        ARRIVE(3);
        side_outputs(F);
        WAIT(3);
        }
    }
    if (IN(4)) {
        bf16_t* MG = F.H;
        pg8::Gemm g{F.A1, F.A2, F.Wa_t, F.Wb_t, NQ, PK_A12, PK_WAB}; pg8::Order S; S.init(M, DM, F.G, (int)blockIdx.x, 1, F.vcu, 1, WGM2);
        Epi2 E{MG, F.SMG};
        for (int rep = 0; rep < REP[4]; ++rep) pg8::gemm_phase<Epi2, true, true, true>(F.lds + RING_OFF, g, S, E);
        SEAM(4);
    }
    if (IN(5)) {
        pg8::Gemm g{F.H, F.H, F.Wo_t, F.Wo_t, DM, PK_MG, PK_WO}; pg8::Order S; S.init(M, DM, F.G, (int)blockIdx.x, 0, F.vcu, 1, WGM3);
        Epi3 E{F.gate, (bf16_t*)(ws + WS_YPRE)};
        for (int rep = 0; rep < REP[5]; ++rep) pg8::gemm_phase<Epi3, true, true, true>(F.lds + RING_OFF, g, S, E);
        SEAM(5);
    }
    if (IN(6)) p6_final(F, (const bf16_t*)(ws + WS_YPRE));
#undef IN
#undef SEAM
#undef ARRIVE
#undef WAIT
}

extern "C" void kernel_launch(void* const* d_in, const int* in_sizes, int n_in, void* d_out, int out_size, void* d_ws, size_t ws_size, hipStream_t stream) {
    static int grid = 0;
    if (grid == 0) {
        if (n_in != 20 || (size_t)out_size != OUT_TOTAL || ws_size < WS_END) { fprintf(stderr, "kernel_launch: unexpected shapes (n_in %d, out %d, ws %zu); nothing launched\n", n_in, out_size, ws_size); grid = -1; return; }
        int dev = 0, cus = 0;
        if (hipGetDevice(&dev) != hipSuccess || hipDeviceGetAttribute(&cus, hipDeviceAttributeMultiprocessorCount, dev) != hipSuccess) { grid = -1; return; }
        if (hipFuncSetAttribute((const void*)skel_fwd, hipFuncAttributeMaxDynamicSharedMemorySize, LDS_BYTES) != hipSuccess) { fprintf(stderr, "kernel_launch: hipFuncSetAttribute failed\n"); grid = -1; return; }
        int per_cu = 0;
        if (hipOccupancyMaxActiveBlocksPerMultiprocessor(&per_cu, (const void*)skel_fwd, NWAVES * 64, LDS_BYTES) != hipSuccess || per_cu < 1) fprintf(stderr, "kernel_launch: occupancy query reports %d\n", per_cu);
        (void)hipGetLastError();
        grid = cus;
    }
    if (grid < 0) return;
    if (hipMemsetAsync((char*)d_ws + WS_CTL, 0, CTL_ZERO_BYTES, stream) != hipSuccess) return;
    Args a{};
    for (int i = 0; i < 20; ++i) a.in[i] = (const float*)d_in[i];
    a.out = (float*)d_out; a.ws = (unsigned char*)d_ws;
#if MK_N_LAUNCHES == 1
    a.ph_lo = 0; a.ph_hi = N_PHASES;
    hipLaunchKernelGGL(skel_fwd, dim3(grid), dim3(NWAVES * 64), LDS_BYTES, stream, a);
#else
    for (int p = 0; p < N_PHASES; ++p) { a.ph_lo = p; a.ph_hi = p + 1; hipLaunchKernelGGL(skel_fwd, dim3(grid), dim3(NWAVES * 64), LDS_BYTES, stream, a); }
#endif
}
```
